# Optimizing an MI355X kernel written in HIP

```python
import jax, jax.numpy as jnp
from jax import lax
import numpy as np

D_MODEL = 1024
BATCH = 8
SEQ = 4096
DEPTH = 1
DEC_BATCH = 2
DEC_SEQ = 8192
PAST_LEN = 128

N_META = 16
GRID_W = 64
EPS = 1e-6
NEG = -1e30
NA_HEADS = 8
NA_HEAD_DIM = 64
NA_WIDTH = NA_HEADS * NA_HEAD_DIM
NA_WIN_ROWS = 8
NA_WIN_COLS = 16
NA_QBLOCK = 16
NA_KCOLS = 32
ML_HEADS = 4
ML_HEAD_DIM = 128
ML_WIDTH = ML_HEADS * ML_HEAD_DIM
ML_CHUNK = 64
ML_CONV = 3
SPLITS = (NA_WIDTH, NA_WIDTH, NA_WIDTH, NA_WIDTH, 2 * ML_WIDTH, ML_WIDTH, ML_WIDTH, ML_WIDTH, 4 * ML_HEADS, 2 * D_MODEL)
N_IN = sum(SPLITS)
SPLIT_IDX = tuple(int(s) for s in np.cumsum(SPLITS)[:-1])
GATE_OFF = 4 * NA_WIDTH + 5 * ML_WIDTH

kernel_name = 'hybrid_na_mlstm_encoder'


def _rmsnorm(x, g):
    xf = x.astype(jnp.float32)
    y = xf * lax.rsqrt(jnp.mean(xf * xf, axis=-1, keepdims=True) + EPS)
    return (y * g.astype(jnp.float32)).astype(x.dtype)


def _na_column_tables():
    n_cb = GRID_W // NA_QBLOCK
    c = np.arange(GRID_W).reshape(n_cb, NA_QBLOCK)
    c0 = np.clip(c - NA_WIN_COLS // 2, 0, GRID_W - NA_WIN_COLS)
    kc0 = np.clip(np.arange(n_cb) * NA_QBLOCK - NA_WIN_COLS // 2, 0, GRID_W - NA_KCOLS)
    kc = kc0[:, None] + np.arange(NA_KCOLS)[None]
    valid = (kc[:, None, :] >= c0[..., None]) & (kc[:, None, :] < c0[..., None] + NA_WIN_COLS)
    dc = np.clip(kc[:, None, :] - c[..., None] + NA_WIN_COLS - 1, 0, 2 * NA_WIN_COLS - 2)
    return kc, valid, dc


def _neighbourhood_attention(q, k, v, rpb):
    B, L, H, dh = q.shape
    T = L - N_META
    rows = T // GRID_W
    wr = min(NA_WIN_ROWS, rows)
    n_cb = GRID_W // NA_QBLOCK
    scale = dh ** -0.5
    kc, valid, dc = _na_column_tables()
    qm, km, vm = q[:, :N_META], k[:, :N_META], v[:, :N_META]
    s_mm = jnp.einsum('bqhd,bkhd->bhqk', qm, km).astype(jnp.float32) * scale
    p_mm = jax.nn.softmax(s_mm, axis=-1).astype(v.dtype)
    out_meta = jnp.einsum('bhqk,bkhd->bqhd', p_mm, vm)
    qg = q[:, N_META:].reshape(B, rows, n_cb, NA_QBLOCK, H, dh)
    kg = k[:, N_META:].reshape(B, rows, GRID_W, H, dh)
    vg = v[:, N_META:].reshape(B, rows, GRID_W, H, dh)
    bias_tab = rpb.astype(jnp.float32)[:, :, dc]

    def row_block(r):
        r0 = jnp.clip(r - wr // 2, 0, rows - wr)
        k_blk = lax.dynamic_slice_in_dim(kg, r0, wr, axis=1)[:, :, kc]
        v_blk = lax.dynamic_slice_in_dim(vg, r0, wr, axis=1)[:, :, kc]
        q_blk = lax.dynamic_index_in_dim(qg, r, axis=1, keepdims=False)
        s_win = jnp.einsum('bcqhd,bwckhd->bhcqwk', q_blk, k_blk).astype(jnp.float32) * scale
        dr = r0 + jnp.arange(wr) - r + (NA_WIN_ROWS - 1)
        bias = jnp.take(bias_tab, dr, axis=1).transpose(0, 2, 3, 1, 4)
        s_win = jnp.where(valid[:, :, None, :], s_win + bias, NEG)
        s_win = s_win.reshape(B, H, n_cb, NA_QBLOCK, wr * NA_KCOLS)
        s_met = jnp.einsum('bcqhd,bmhd->bhcqm', q_blk, km).astype(jnp.float32) * scale
        p = jax.nn.softmax(jnp.concatenate([s_met, s_win], axis=-1), axis=-1).astype(v.dtype)
        p_met = p[..., :N_META]
        p_win = p[..., N_META:].reshape(B, H, n_cb, NA_QBLOCK, wr, NA_KCOLS)
        return (jnp.einsum('bhcqm,bmhd->bcqhd', p_met, vm)
                + jnp.einsum('bhcqwk,bwckhd->bcqhd', p_win, v_blk))

    out = lax.map(row_block, jnp.arange(rows))
    out_grid = jnp.moveaxis(out, 0, 1).reshape(B, T, H, dh)
    return jnp.concatenate([out_meta, out_grid], axis=1)


def _mlstm_chunkwise(q, k, v, ig, lf):
    B, H, L, d = q.shape
    nc = L // ML_CHUNK
    q = q.reshape(B, H, nc, ML_CHUNK, d)
    k = k.reshape(B, H, nc, ML_CHUNK, d)
    v = v.reshape(B, H, nc, ML_CHUNK, d)
    ig = ig.reshape(B, H, nc, ML_CHUNK)
    lf = lf.reshape(B, H, nc, ML_CHUNK)
    b = jnp.cumsum(lf, axis=-1)
    g = b[..., -1]
    a = g[..., None] - b + ig
    m_loc = jnp.max(a, axis=-1)
    w = jnp.exp(a - m_loc[..., None])
    dC = jnp.einsum('bhnsv,bhnsk->bhnvk', w[..., None] * v, k)
    dn = jnp.einsum('bhns,bhnsk->bhnk', w, k)

    def step(carry, xs):
        C, n, m = carry
        g_c, ml_c, dC_c, dn_c = xs
        m_new = jnp.maximum(g_c + m, ml_c)
        fs = jnp.exp(g_c + m - m_new)
        isc = jnp.exp(ml_c - m_new)
        C_new = fs[..., None, None] * C + isc[..., None, None] * dC_c
        n_new = fs[..., None] * n + isc[..., None] * dn_c
        return (C_new, n_new, m_new), (C, n, m)

    init = (jnp.zeros((B, H, d, d), q.dtype), jnp.zeros((B, H, d), q.dtype), jnp.zeros((B, H), q.dtype))
    xs = (jnp.moveaxis(g, 2, 0), jnp.moveaxis(m_loc, 2, 0), jnp.moveaxis(dC, 2, 0), jnp.moveaxis(dn, 2, 0))
    _, (Cs, ns, ms) = lax.scan(step, init, xs)
    Cs = jnp.moveaxis(Cs, 0, 2)
    ns = jnp.moveaxis(ns, 0, 2)
    ms = jnp.moveaxis(ms, 0, 2)
    lower = np.tril(np.ones((ML_CHUNK, ML_CHUNK), dtype=bool))
    logD = jnp.where(lower, b[..., :, None] - b[..., None, :] + ig[..., None, :], NEG)
    inter = b + ms[..., None]
    m_t = jnp.maximum(jnp.max(logD, axis=-1), inter)
    S = jnp.einsum('bhnjd,bhnsd->bhnjs', q, k) * jnp.exp(logD - m_t[..., None])
    e_inter = jnp.exp(inter - m_t)
    num = jnp.einsum('bhnjs,bhnsv->bhnjv', S, v) + e_inter[..., None] * jnp.einsum('bhnvk,bhnjk->bhnjv', Cs, q)
    den = jnp.sum(S, axis=-1) + e_inter * jnp.einsum('bhnk,bhnjk->bhnj', ns, q)
    h = num / jnp.maximum(jnp.abs(den), jnp.exp(-m_t))[..., None]
    return h.reshape(B, H, L, d)


def _mlstm_branch(qk_pre, v, gate_pre, o_pre, conv_w, head_g):
    B, L, _ = v.shape
    f32 = jnp.float32
    cw = conv_w.astype(qk_pre.dtype)[:, None, :]
    qk = jax.nn.silu(lax.conv_general_dilated(qk_pre, cw, (1,), 'SAME',
                                              dimension_numbers=('NWC', 'WIO', 'NWC'),
                                              feature_group_count=qk_pre.shape[-1]))
    q, k = jnp.split(qk, 2, axis=-1)

    def heads(t):
        return t.astype(f32).reshape(B, L, ML_HEADS, ML_HEAD_DIM).transpose(0, 2, 1, 3)

    q, k, vh = heads(q), heads(k) * (ML_HEAD_DIM ** -0.5), heads(v)
    gates = gate_pre.astype(f32).reshape(B, L, 4, ML_HEADS).transpose(2, 0, 3, 1)
    ig_f, lf_f = gates[0], jax.nn.log_sigmoid(gates[1])
    ig_b, lf_b = gates[2], jax.nn.log_sigmoid(gates[3])
    P = ML_CHUNK - N_META

    def pad_t(t, val):
        return jnp.pad(t, [(0, 0), (0, 0), (P, 0)] + [(0, 0)] * (t.ndim - 3), constant_values=val)

    def flip(t):
        return jnp.flip(t, axis=2)

    qp, kp, vp = pad_t(q, 0.0), pad_t(k, 0.0), pad_t(vh, 0.0)
    h_f = _mlstm_chunkwise(qp, kp, vp, pad_t(ig_f, NEG), pad_t(lf_f, 0.0))
    h_b = flip(_mlstm_chunkwise(flip(qp), flip(kp), flip(vp), flip(pad_t(ig_b, NEG)), flip(pad_t(lf_b, 0.0))))
    h = (h_f + h_b)[:, :, P:].transpose(0, 2, 1, 3)
    h = jax.nn.sigmoid(o_pre.astype(f32)).reshape(B, L, ML_HEADS, ML_HEAD_DIM) * h
    mu = jnp.mean(h, axis=-1, keepdims=True)
    var = jnp.mean(jnp.square(h - mu), axis=-1, keepdims=True)
    h = (h - mu) * lax.rsqrt(var + EPS)
    return (h.reshape(B, L, ML_WIDTH) * head_g.astype(f32)).astype(v.dtype)


def _encoder_layer(h, g_pre, w_in, b_in, na_rpb, ml_conv_w, ml_head_g, w_a, w_b, w_out, g_post):
    B, L, _ = h.shape
    xn = _rmsnorm(h, g_pre)
    proj = xn @ w_in + b_in.astype(xn.dtype)
    na_q, na_k, na_v, na_z, ml_qk, ml_v, ml_z, ml_o, ml_g, mg = jnp.split(proj, SPLIT_IDX, axis=-1)
    hd = (B, L, NA_HEADS, NA_HEAD_DIM)
    ya = _neighbourhood_attention(na_q.reshape(hd), na_k.reshape(hd), na_v.reshape(hd), na_rpb)
    ya = (ya.reshape(B, L, NA_WIDTH) * jax.nn.silu(na_z)) @ w_a
    yb = (_mlstm_branch(ml_qk, ml_v, ml_g, ml_o, ml_conv_w, ml_head_g) * jax.nn.silu(ml_z)) @ w_b
    ga, gb = jnp.split(jax.nn.sigmoid(mg), 2, axis=-1)
    y = (ga * ya + gb * yb) @ w_out
    return h + _rmsnorm(y, g_post)


def _encoder_trunk(x, meta_tokens, g_pre, w_in, b_in, na_rpb, ml_conv_w, ml_head_g, w_a, w_b, w_out, g_post):
    B = x.shape[0]
    meta = jnp.broadcast_to(meta_tokens.astype(x.dtype)[None], (B, N_META, x.shape[-1]))
    h = jnp.concatenate([meta, x], axis=1)
    for l in range(DEPTH):
        h = _encoder_layer(h, g_pre[l], w_in[l], b_in[l], na_rpb[l], ml_conv_w[l], ml_head_g[l],
                           w_a[l], w_b[l], w_out[l], g_post[l])
    return h[:, N_META:]


def setup_inputs(seed: int = 0) -> dict:
    key = jax.random.key(seed)
    ks = jax.random.split(key, 16)
    f32 = jnp.float32
    nrm = jax.random.normal
    x_prompt = nrm(ks[0], (BATCH, SEQ, D_MODEL), f32)
    x_sample = nrm(ks[1], (DEC_BATCH, DEC_SEQ, D_MODEL), f32)
    meta_tokens = nrm(ks[2], (N_META, D_MODEL), f32)
    g_pre = 1.0 + 0.02 * nrm(ks[3], (DEPTH, D_MODEL), f32)
    w_in = nrm(ks[4], (DEPTH, D_MODEL, N_IN), f32) * (D_MODEL ** -0.5)
    b_in = 0.02 * nrm(ks[5], (DEPTH, N_IN), f32)
    fb = jnp.linspace(3.0, 6.0, ML_HEADS, dtype=f32)
    b_in = b_in.at[:, GATE_OFF + ML_HEADS:GATE_OFF + 2 * ML_HEADS].add(fb)
    b_in = b_in.at[:, GATE_OFF + 3 * ML_HEADS:GATE_OFF + 4 * ML_HEADS].add(fb)
    na_rpb = 0.1 * nrm(ks[6], (DEPTH, NA_HEADS, 2 * NA_WIN_ROWS - 1, 2 * NA_WIN_COLS - 1), f32)
    ml_conv_w = nrm(ks[7], (DEPTH, ML_CONV, 2 * ML_WIDTH), f32) * (ML_CONV ** -0.5)
    ml_head_g = 1.0 + 0.02 * nrm(ks[8], (DEPTH, ML_WIDTH), f32)
    w_a = nrm(ks[9], (DEPTH, NA_WIDTH, D_MODEL), f32) * (NA_WIDTH ** -0.5)
    w_b = nrm(ks[10], (DEPTH, ML_WIDTH, D_MODEL), f32) * (ML_WIDTH ** -0.5)
    w_out = nrm(ks[11], (DEPTH, D_MODEL, D_MODEL), f32) * (D_MODEL ** -0.5)
    g_post = 1.0 + 0.02 * nrm(ks[12], (DEPTH, D_MODEL), f32)
    return {'x_prompt': x_prompt, 'x_sample': x_sample, 'meta_tokens': meta_tokens, 'g_pre': g_pre,
            'w_in': w_in, 'b_in': b_in, 'na_rpb': na_rpb, 'ml_conv_w': ml_conv_w, 'ml_head_g': ml_head_g,
            'w_a': w_a, 'w_b': w_b, 'w_out': w_out, 'g_post': g_post}


def reference(x_prompt, x_sample, meta_tokens, g_pre, w_in, b_in, na_rpb, ml_conv_w, ml_head_g, w_a, w_b, w_out, g_post):
    y_prompt = _encoder_trunk(x_prompt, meta_tokens, g_pre, w_in, b_in, na_rpb, ml_conv_w, ml_head_g,
                              w_a, w_b, w_out, g_post)
    y_sample = _encoder_trunk(x_sample, meta_tokens, g_pre, w_in, b_in, na_rpb, ml_conv_w, ml_head_g,
                              w_a, w_b, w_out, g_post)
    return (y_prompt, y_sample)
```

```cpp
#include <hip/hip_runtime.h>
#include <hip/hip_cooperative_groups.h>
#include <cstdio>
#include <cstdint>
namespace cg = cooperative_groups;
namespace pg8 {
#define PG8_LAS __attribute__((address_space(3)))
typedef unsigned short bf16_t;
typedef short bf16x8 __attribute__((ext_vector_type(8)));
typedef float f32x4 __attribute__((ext_vector_type(4)));
typedef unsigned u32x4 __attribute__((ext_vector_type(4)));
constexpr int BM = 256, BK = 64, HALF = 128, HTB = HALF * BK * 2  , STAGE_BYTES = 8 * HTB, NXCD = 8, WGM = 8;

__host__ __device__ __forceinline__ int lds_byte(int r, int c) { const int st = (r >> 4) * 2 + (c >> 5), rr = r & 15, cc = c & 31, ob = rr * 64 + cc * 2; return st * 1024 + (ob ^ (((ob >> 9) & 1) << 5)); }
__host__ __device__ __forceinline__ void stage_rc(int b, int& R, int& C) { const int st = b / 1024, sb = b % 1024, swz = sb ^ (((sb >> 9) & 1) << 5); R = (st >> 1) * 16 + swz / 64; C = (st & 1) * 32 + (swz % 64) / 2; }
__host__ __device__ __forceinline__ int perm32(int rho) { const int n = rho >> 4, i = rho & 15; return 8 * (i >> 2) + 4 * n + (i & 3); }

struct Unit { int pm, pn; };
struct Gemm { const bf16_t* A; const bf16_t* Bt; int M, N, K, lda, ldb; };

struct StaticOrder {
    int nM, nN, nwg, G, c;
    __host__ __device__ void init(int M, int N, int G_, int c_) { nM = M / BM; nN = N / BM; nwg = nM * nN; G = G_; c = c_; }
    __host__ __device__ bool next(int i, Unit& u) const {
        const long L = (long)i * G + c; if (L >= nwg) return false;
        int wgid = (int)L; { const int q = nwg / NXCD, r = nwg % NXCD, xcd = wgid % NXCD, off = wgid / NXCD; wgid = (xcd < r ? xcd * (q + 1) : r * (q + 1) + (xcd - r) * q) + off; }
        const int nig = WGM * nN, gid = wgid / nig, fm = gid * WGM, gsz = (nM - fm) < WGM ? (nM - fm) : WGM;
        u.pm = fm + ((wgid % nig) % gsz); u.pn = (wgid % nig) / gsz; return true;
    }
    __device__ __forceinline__ void a_ready(const Unit&) const {}
    __device__ __forceinline__ void done(const Unit&) const {}
};

__device__ __forceinline__ unsigned cvt_pk_bf16(float lo, float hi) { unsigned r; asm volatile("v_cvt_pk_bf16_f32 %0, %1, %2" : "=v"(r) : "v"(lo), "v"(hi)); return r; }
typedef unsigned u32x2 __attribute__((ext_vector_type(2)));
__device__ __forceinline__ float bf2f(unsigned u16) { return __uint_as_float(u16 << 16); }
__device__ __forceinline__ float sigmoidf_(float x) { return 1.0f / (1.0f + __expf(-x)); }
constexpr int P1_NT_PROJ = 18, P1_NT_MG = 8;
constexpr int LDP = 4608;
constexpr int MGQ_SPLIT_ROW = 48384;

struct EpiProj {
    static constexpr bool PERM = true, AFTER_DRAIN = false;
    bf16_t* proj; unsigned char* mgq_lo; unsigned char* mgq_hi; float* gates; const float* bias;
    __device__ __forceinline__ void operator()(const f32x4 (&acc)[2][2][4][2], const Unit& u, int wr, int wc, int fr, int fq) const {
        const int row0 = u.pm * BM + wr * 64 + fr; const int cl = wc * 32 + 8 * fq; const int bcol0 = u.pn * BM + cl;
        f32x4 bv[2][2];
#pragma unroll
        for (int bj = 0; bj < 2; ++bj)
#pragma unroll
            for (int n = 0; n < 2; ++n) bv[bj][n] = *(const f32x4*)(bias + bcol0 + bj * HALF + 4 * n);
        if (u.pn < P1_NT_PROJ) {
#pragma unroll
            for (int ai = 0; ai < 2; ++ai)
#pragma unroll
                for (int m = 0; m < 4; ++m) { bf16_t* rowp = proj + (size_t)(row0 + ai * HALF + m * 16) * LDP + bcol0;
#pragma unroll
                    for (int bj = 0; bj < 2; ++bj) { const f32x4 v0 = acc[ai][bj][m][0] + bv[bj][0], v1 = acc[ai][bj][m][1] + bv[bj][1];
                        u32x4 w; w.x = cvt_pk_bf16(v0[0], v0[1]); w.y = cvt_pk_bf16(v0[2], v0[3]); w.z = cvt_pk_bf16(v1[0], v1[1]); w.w = cvt_pk_bf16(v1[2], v1[3]);
                        *(u32x4*)(rowp + bj * HALF) = w; } }
        } else if (u.pn < P1_NT_PROJ + P1_NT_MG) {
            const int gc0 = (u.pn - P1_NT_PROJ) * BM + cl;
#pragma unroll
            for (int ai = 0; ai < 2; ++ai)
#pragma unroll
                for (int m = 0; m < 4; ++m) { const int row = row0 + ai * HALF + m * 16;
                    unsigned char* rowp = (row < MGQ_SPLIT_ROW ? mgq_lo + (size_t)row * 2048 : mgq_hi + (size_t)(row - MGQ_SPLIT_ROW) * 2048) + gc0;
#pragma unroll
                    for (int bj = 0; bj < 2; ++bj) { const f32x4 v0 = acc[ai][bj][m][0] + bv[bj][0], v1 = acc[ai][bj][m][1] + bv[bj][1];
                        unsigned q[8];
#pragma unroll
                        for (int e = 0; e < 4; ++e) { q[e] = (unsigned)(sigmoidf_(v0[e]) * 255.0f + 0.5f); q[4 + e] = (unsigned)(sigmoidf_(v1[e]) * 255.0f + 0.5f); }
                        u32x2 w; w.x = q[0] | (q[1] << 8) | (q[2] << 16) | (q[3] << 24); w.y = q[4] | (q[5] << 8) | (q[6] << 16) | (q[7] << 24);
                        *(u32x2*)(rowp + bj * HALF) = w; } }
        } else {
            if (wc == 0 && fq < 2) {
#pragma unroll
                for (int ai = 0; ai < 2; ++ai)
#pragma unroll
                    for (int m = 0; m < 4; ++m) { float* gp = gates + (size_t)(row0 + ai * HALF + m * 16) * 16 + 8 * fq;
                        *(f32x4*)(gp) = acc[ai][0][m][0] + bv[0][0]; *(f32x4*)(gp + 4) = acc[ai][0][m][1] + bv[0][1]; }
            }
        }
    }
};
__device__ __forceinline__ const unsigned char* mgq_row(const unsigned char* lo, const unsigned char* hi, int row) { return row < MGQ_SPLIT_ROW ? lo + (size_t)row * 2048 : hi + (size_t)(row - MGQ_SPLIT_ROW) * 2048; }
template <bool SECOND> struct EpiMix {
    static constexpr bool PERM = true, AFTER_DRAIN = false;
    bf16_t* mix; const unsigned char* mgq_lo; const unsigned char* mgq_hi;
    __device__ __forceinline__ void operator()(const f32x4 (&acc)[2][2][4][2], const Unit& u, int wr, int wc, int fr, int fq) const {
        const int row0 = u.pm * BM + wr * 64 + fr; const int col0 = u.pn * BM + wc * 32 + 8 * fq;
#pragma unroll
        for (int ai = 0; ai < 2; ++ai)
#pragma unroll
            for (int m = 0; m < 4; ++m) { const int row = row0 + ai * HALF + m * 16; bf16_t* rowp = mix + (size_t)row * LDP + col0;
                const unsigned char* gp = mgq_row(mgq_lo, mgq_hi, row) + (SECOND ? 1024 : 0) + col0;
#pragma unroll
                for (int bj = 0; bj < 2; ++bj) { const u32x2 gq = *(const u32x2*)(gp + bj * HALF); float g[8];
#pragma unroll
                    for (int e = 0; e < 4; ++e) { g[e] = (float)((gq.x >> (8 * e)) & 255u) * (1.0f / 255.0f); g[4 + e] = (float)((gq.y >> (8 * e)) & 255u) * (1.0f / 255.0f); }
                    float v[8];
#pragma unroll
                    for (int e = 0; e < 4; ++e) { v[e] = acc[ai][bj][m][0][e] * g[e]; v[4 + e] = acc[ai][bj][m][1][e] * g[4 + e]; }
                    if (SECOND) { const u32x4 old = *(const u32x4*)(rowp + bj * HALF);
                        v[0] += bf2f(old.x & 0xffffu); v[1] += bf2f(old.x >> 16); v[2] += bf2f(old.y & 0xffffu); v[3] += bf2f(old.y >> 16);
                        v[4] += bf2f(old.z & 0xffffu); v[5] += bf2f(old.z >> 16); v[6] += bf2f(old.w & 0xffffu); v[7] += bf2f(old.w >> 16); }
                    u32x4 w; w.x = cvt_pk_bf16(v[0], v[1]); w.y = cvt_pk_bf16(v[2], v[3]); w.z = cvt_pk_bf16(v[4], v[5]); w.w = cvt_pk_bf16(v[6], v[7]);
                    *(u32x4*)(rowp + bj * HALF) = w; } }
    }
};
struct EpiY {
    static constexpr bool PERM = true, AFTER_DRAIN = false;
    bf16_t* y; float* ss;
    __device__ __forceinline__ void operator()(const f32x4 (&acc)[2][2][4][2], const Unit& u, int wr, int wc, int fr, int fq) const {
        const int row0 = u.pm * BM + wr * 64 + fr; const int col0 = u.pn * BM + wc * 32 + 8 * fq;
#pragma unroll
        for (int ai = 0; ai < 2; ++ai)
#pragma unroll
            for (int m = 0; m < 4; ++m) { const int row = row0 + ai * HALF + m * 16; bf16_t* rowp = y + (size_t)row * LDP + col0; float s = 0.f;
#pragma unroll
                for (int bj = 0; bj < 2; ++bj) { const f32x4 v0 = acc[ai][bj][m][0], v1 = acc[ai][bj][m][1];
                    s += (v0[0] * v0[0] + v0[1] * v0[1]) + (v0[2] * v0[2] + v0[3] * v0[3]) + (v1[0] * v1[0] + v1[1] * v1[1]) + (v1[2] * v1[2] + v1[3] * v1[3]);
                    u32x4 w; w.x = cvt_pk_bf16(v0[0], v0[1]); w.y = cvt_pk_bf16(v0[2], v0[3]); w.z = cvt_pk_bf16(v1[0], v1[1]); w.w = cvt_pk_bf16(v1[2], v1[3]);
                    *(u32x4*)(rowp + bj * HALF) = w; }
                s += __shfl_xor(s, 16); s += __shfl_xor(s, 32);
                if (fq == 0) ss[(size_t)row * 16 + u.pn * 4 + wc] = s; }
    }
};
template <class Epi, class Sched, bool ALIGN_EPI = false, bool SP2 = false>
__device__ __forceinline__ void gemm_phase(PG8_LAS unsigned char* lds, const Gemm g, const Sched& S, const Epi& E) {
    const int tid = threadIdx.x, wid = __builtin_amdgcn_readfirstlane(tid >> 6), lane = tid & 63, wr = wid >> 2, wc = wid & 3, fr = lane & 15, fq = lane >> 4;
    const int K = g.K, nt = K / BK;
    unsigned voffA[2], voffB[2];
#pragma unroll
    for (int i = 0; i < 2; ++i) { int R, C; stage_rc(tid * 16 + i * 8192, R, C); const int Rb = Epi::PERM ? ((R & ~31) + perm32(R & 31)) : R;
        voffA[i] = (unsigned)(R * g.lda + C) * 2u; voffB[i] = (unsigned)(Rb * g.ldb + C) * 2u; }
    const size_t kstep = (size_t)(BK * 2);
    const size_t hstepA = (size_t)HALF * g.lda * 2, hstepB = (size_t)HALF * g.ldb * 2;
    const size_t tstepA = 2 * hstepA, tstepB = 2 * hstepB;
    const unsigned ldsw = (unsigned)wid * 1024u;
    const int aoff = lds_byte(wr * 64 + fr, fq * 8), boff = lds_byte(wc * 32 + fr, fq * 8);
#define PG8_SA(b, h) (((b) * 2 + (h)) * HTB)
#define PG8_SB(b, h) ((4 + (b) * 2 + (h)) * HTB)
#define PG8_STAGE(bufoff, gbase, voff) do { _Pragma("unroll") for (int _i = 0; _i < 2; ++_i) \
        __builtin_amdgcn_global_load_lds((const unsigned*)((const char*)(gbase) + (voff)[_i]), (PG8_LAS unsigned*)(lds + (bufoff) + ldsw + _i * 8192), 16, 0, 0); } while (0)
#define PG8_LDA(dst, b, h) do { _Pragma("unroll") for (int m = 0; m < 4; ++m) _Pragma("unroll") for (int k = 0; k < 2; ++k) dst[m][k] = *(const PG8_LAS bf16x8*)(lds + PG8_SA(b, h) + aoff + m * 2048 + k * 1024); } while (0)
#define PG8_LDB(dst, b, h) do { _Pragma("unroll") for (int n = 0; n < 2; ++n) _Pragma("unroll") for (int k = 0; k < 2; ++k) dst[n][k] = *(const PG8_LAS bf16x8*)(lds + PG8_SB(b, h) + boff + n * 2048 + k * 1024); } while (0)
#define PG8_MMA(ai, bj, At, Bt) do { __builtin_amdgcn_s_setprio(1); _Pragma("unroll") for (int m = 0; m < 4; ++m) _Pragma("unroll") for (int n = 0; n < 2; ++n) _Pragma("unroll") for (int k = 0; k < 2; ++k) \
        acc[ai][bj][m][n] = __builtin_amdgcn_mfma_f32_16x16x32_bf16(Bt[n][k], At[m][k], acc[ai][bj][m][n], 0, 0, 0); __builtin_amdgcn_s_setprio(0); } while (0)
#define PG8_WAIT_V(n) asm volatile("s_waitcnt vmcnt(" #n ")" ::: "memory")
#define PG8_WAIT_L(n) asm volatile("s_waitcnt lgkmcnt(" #n ")" ::: "memory")
#define PG8_BAR __builtin_amdgcn_s_barrier()
#define PG8_SCHED __builtin_amdgcn_sched_barrier(0)
    Unit cur, nxt; int ui = 0;
    if (!S.next(0, cur)) return;
    f32x4 acc[2][2][4][2];
#pragma unroll
    for (int a = 0; a < 2; ++a)
#pragma unroll
        for (int b = 0; b < 2; ++b)
#pragma unroll
            for (int m = 0; m < 4; ++m)
#pragma unroll
                for (int n = 0; n < 2; ++n) acc[a][b][m][n] = (f32x4){0.f, 0.f, 0.f, 0.f};
    bf16x8 At[4][2], B0[2][2], B1[2][2];
    const char* cA = (const char*)g.A + (size_t)cur.pm * tstepA; const char* cB = (const char*)g.Bt + (size_t)cur.pn * tstepB;
    S.a_ready(cur);
    if constexpr (SP2) {
        PG8_STAGE(PG8_SB(0, 0), cB, voffB); PG8_STAGE(PG8_SB(0, 1), cB + hstepB, voffB); PG8_STAGE(PG8_SA(0, 0), cA, voffA); PG8_STAGE(PG8_SA(0, 1), cA + hstepA, voffA);
        if (wr == 1) PG8_BAR;
        PG8_WAIT_V(2); PG8_BAR;
        PG8_STAGE(PG8_SB(1, 0), cB + kstep, voffB); PG8_STAGE(PG8_SA(1, 0), cA + kstep, voffA); PG8_STAGE(PG8_SB(1, 1), cB + hstepB + kstep, voffB);
        PG8_WAIT_V(6); PG8_BAR;
    } else {
        PG8_STAGE(PG8_SB(0, 0), cB, voffB); PG8_STAGE(PG8_SA(0, 0), cA, voffA); PG8_STAGE(PG8_SB(0, 1), cB + hstepB, voffB); PG8_STAGE(PG8_SA(0, 1), cA + hstepA, voffA);
        if (wr == 1) PG8_BAR;
        PG8_WAIT_V(4); PG8_BAR;
        PG8_STAGE(PG8_SB(1, 0), cB + kstep, voffB); PG8_STAGE(PG8_SA(1, 0), cA + kstep, voffA); PG8_STAGE(PG8_SB(1, 1), cB + hstepB + kstep, voffB);
        PG8_WAIT_V(6); PG8_BAR;
    }
    for (;;) {
        const bool has_next = S.next(ui + 1, nxt);
        const char* nA = has_next ? (const char*)g.A + (size_t)nxt.pm * tstepA : cA; const char* nB = has_next ? (const char*)g.Bt + (size_t)nxt.pn * tstepB : cB;
        for (int t = 0; t < nt; t += 2) {
            const bool last = (t == nt - 2);
            const char* a1 = cA + (size_t)(t + 1) * kstep;
            const char* a2 = last ? nA : cA + (size_t)(t + 2) * kstep; const char* b2 = last ? nB : cB + (size_t)(t + 2) * kstep;
            const char* a3 = a2 + kstep; const char* b3 = b2 + kstep;
            if (last && has_next) S.a_ready(nxt);
            if constexpr (SP2) {
            PG8_LDB(B0, 0, 0); PG8_LDB(B1, 0, 1); PG8_SCHED; PG8_LDA(At, 0, 0); PG8_STAGE(PG8_SA(1, 1), a1 + hstepA, voffA);
            PG8_WAIT_V(8); PG8_WAIT_L(0); PG8_BAR; PG8_MMA(0, 0, At, B0); PG8_MMA(0, 1, At, B1); PG8_BAR; PG8_SCHED;
            PG8_LDA(At, 0, 1); PG8_STAGE(PG8_SB(0, 0), b2, voffB); PG8_STAGE(PG8_SB(0, 1), b2 + hstepB, voffB); PG8_STAGE(PG8_SA(0, 0), a2, voffA);
            PG8_WAIT_V(8); PG8_WAIT_L(0); PG8_BAR; PG8_MMA(1, 0, At, B0); PG8_MMA(1, 1, At, B1); PG8_BAR; PG8_SCHED;
            PG8_LDB(B0, 1, 0); PG8_LDB(B1, 1, 1); PG8_SCHED; PG8_LDA(At, 1, 0); PG8_STAGE(PG8_SA(0, 1), a2 + hstepA, voffA);
            PG8_WAIT_V(8); PG8_WAIT_L(0); PG8_BAR; PG8_MMA(0, 0, At, B0); PG8_MMA(0, 1, At, B1); PG8_BAR; PG8_SCHED;
            PG8_LDA(At, 1, 1); PG8_STAGE(PG8_SB(1, 0), b3, voffB); PG8_STAGE(PG8_SB(1, 1), b3 + hstepB, voffB); PG8_STAGE(PG8_SA(1, 0), a3, voffA);
            PG8_WAIT_V(8); PG8_WAIT_L(0); PG8_BAR; PG8_MMA(1, 0, At, B0); PG8_MMA(1, 1, At, B1); PG8_BAR; PG8_SCHED;
            } else {
            PG8_LDB(B0, 0, 0); PG8_SCHED; PG8_LDA(At, 0, 0); PG8_STAGE(PG8_SA(1, 1), a1 + hstepA, voffA);
            PG8_WAIT_L(8); PG8_BAR; PG8_WAIT_L(0); PG8_MMA(0, 0, At, B0); PG8_BAR; PG8_SCHED;
            PG8_LDB(B1, 0, 1); PG8_STAGE(PG8_SB(0, 0), b2, voffB);
            PG8_BAR; PG8_WAIT_L(0); PG8_MMA(0, 1, At, B1); PG8_BAR;
            PG8_LDA(At, 0, 1); PG8_STAGE(PG8_SA(0, 0), a2, voffA);
            PG8_BAR; PG8_WAIT_L(0); PG8_MMA(1, 0, At, B0); PG8_BAR; PG8_SCHED;
            PG8_STAGE(PG8_SB(0, 1), b2 + hstepB, voffB);
            PG8_WAIT_V(6); PG8_BAR; PG8_MMA(1, 1, At, B1); PG8_BAR;
            PG8_LDB(B0, 1, 0); PG8_SCHED; PG8_LDA(At, 1, 0); PG8_STAGE(PG8_SA(0, 1), a2 + hstepA, voffA);
            PG8_WAIT_L(8); PG8_BAR; PG8_WAIT_L(0); PG8_MMA(0, 0, At, B0); PG8_BAR; PG8_SCHED;
            PG8_LDB(B1, 1, 1); PG8_STAGE(PG8_SB(1, 0), b3, voffB);
            PG8_BAR; PG8_WAIT_L(0); PG8_MMA(0, 1, At, B1); PG8_BAR;
            PG8_LDA(At, 1, 1); PG8_STAGE(PG8_SA(1, 0), a3, voffA);
            PG8_BAR; PG8_WAIT_L(0); PG8_MMA(1, 0, At, B0); PG8_BAR; PG8_SCHED;
            PG8_STAGE(PG8_SB(1, 1), b3 + hstepB, voffB);
            PG8_WAIT_V(6); PG8_BAR; PG8_MMA(1, 1, At, B1); PG8_BAR;
            }
        }
        if constexpr (ALIGN_EPI) { if (wr == 0) PG8_BAR; }
        if constexpr (!Epi::AFTER_DRAIN) { E(acc, cur, wr, wc, fr, fq); S.done(cur); }
        if (!has_next) break;
#pragma unroll
        for (int a = 0; a < 2; ++a)
#pragma unroll
            for (int b = 0; b < 2; ++b)
#pragma unroll
                for (int m = 0; m < 4; ++m)
#pragma unroll
                    for (int n = 0; n < 2; ++n) acc[a][b][m][n] = (f32x4){0.f, 0.f, 0.f, 0.f};
        cur = nxt; cA = nA; cB = nB; ++ui;
        if constexpr (ALIGN_EPI) { if (wr == 1) PG8_BAR; }
    }
    PG8_WAIT_V(0);
    if constexpr (!ALIGN_EPI) { if (wr == 0) PG8_BAR; }
    PG8_BAR;
    if constexpr (Epi::AFTER_DRAIN) { E.fused(acc, cur, wr, wc, fr, fq, lds, wid, lane); S.done(cur); }
#undef PG8_SA
#undef PG8_SB
#undef PG8_STAGE
#undef PG8_LDA
#undef PG8_LDB
#undef PG8_MMA
#undef PG8_WAIT_V
#undef PG8_WAIT_L
#undef PG8_BAR
#undef PG8_SCHED
}
}
using pg8::bf16_t; using pg8::LDP; using pg8::bf2f; using pg8::sigmoidf_;
typedef float f32x4 __attribute__((ext_vector_type(4)));
typedef unsigned u32x4 __attribute__((ext_vector_type(4)));
typedef unsigned u32x2 __attribute__((ext_vector_type(2)));
#define LAS __attribute__((address_space(3)))
constexpr int NWAVES = 8, NTHREADS = 512;
constexpr int DM = 1024, NSEQ = 10, NPROMPT = 8, TP = 4096, TS = 8192, LPP = 4160, LPS = 8256;
constexpr int ROWS_P = NPROMPT * LPP;
constexpr int MROWS = ROWS_P + 2 * LPS;
constexpr int MPAD = 49920;
constexpr int NIN = 6672, N1 = 6912;
constexpr int C_NAQ = 0, C_NAK = 512, C_NAV = 1024, C_NAZ = 1536, C_MLQ = 2048, C_MLK = 2560, C_MLV = 3072, C_MLZ = 3584, C_MLO = 4096;
constexpr int C_YA = 0, C_YB = 4096, C_MIX = 2560, C_Y = 1024;
constexpr float EPS = 1e-6f;
constexpr size_t MiB = 1u << 20;
constexpr size_t WS_W1T = 2 * MiB;
constexpr size_t WS_WAT = 16 * MiB, WS_WBT = 17 * MiB, WS_WOT = 18 * MiB;
constexpr size_t WS_BIAS1 = 20 * MiB;
constexpr size_t WS_GATES = 21 * MiB;
constexpr size_t WS_SS = 25 * MiB;
constexpr size_t WS_PROJ = 32 * MiB;
constexpr size_t WS_MGQ_HI = WS_PROJ + (size_t)MPAD * LDP * 2;
constexpr size_t WS_END = WS_MGQ_HI + (size_t)(MPAD - pg8::MGQ_SPLIT_ROW) * 2048;
static_assert(WS_END <= 512 * MiB, "d_ws map");
constexpr size_t DO_XN = 0, DO_HF = 0, DO_HB = (size_t)MPAD * 512 * 2, DO_MGQ_LO = (size_t)MPAD * 1024 * 2;
static_assert(DO_MGQ_LO + (size_t)pg8::MGQ_SPLIT_ROW * 2048 <= (size_t)49152 * 1024 * 4, "d_out map");
constexpr int LDS_BYTES = 147456;

struct Args { const float* in[13]; float* out; unsigned char* ws; int ph_lo, ph_hi, coop, pad; };

__device__ __forceinline__ unsigned f2bf(float f) { unsigned u = __float_as_uint(f); return (u + 0x7fffu + ((u >> 16) & 1u)) >> 16; }
__device__ __forceinline__ unsigned pk2(float lo, float hi) { return f2bf(lo) | (f2bf(hi) << 16); }
__device__ __forceinline__ float siluf_(float x) { return x / (1.0f + __expf(-x)); }
__device__ __forceinline__ float wave_sum(float v) {
#pragma unroll
    for (int o = 1; o < 64; o <<= 1) v += __shfl_xor(v, o);
    return v;
}
__device__ __forceinline__ float wave_max(float v) {
#pragma unroll
    for (int o = 1; o < 64; o <<= 1) v = fmaxf(v, __shfl_xor(v, o));
    return v;
}
__device__ __forceinline__ void row_info(int m, int& b, int& p) {
    if (m < ROWS_P) { b = m / LPP; p = m - b * LPP; }
    else if (m < MROWS) { const int r = m - ROWS_P; const int bb = r / LPS; b = NPROMPT + bb; p = r - bb * LPS; }
    else { b = -1; p = 0; }
}
__device__ __forceinline__ int seq_base(int b) { return b < NPROMPT ? b * LPP : ROWS_P + (b - NPROMPT) * LPS; }
__device__ __forceinline__ int seq_lp(int b) { return b < NPROMPT ? LPP : LPS; }

__device__ __forceinline__ void p0_transpose_item(const float* W, int Nsrc, int K, bf16_t* WT, int src_n0, int dst_row0, int nvalid, int k0, float* scr, int lane) {
#pragma unroll 8
    for (int i = 0; i < 32; ++i) { const int kk = 2 * i + (lane >> 5), n = lane & 31; scr[kk * 33 + n] = (n < nvalid) ? W[(size_t)(k0 + kk) * Nsrc + src_n0 + n] : 0.f; }
    asm volatile("s_waitcnt lgkmcnt(0)" ::: "memory");
    const int c = lane & 7;
#pragma unroll
    for (int j = 0; j < 4; ++j) { const int n = (lane >> 3) + 8 * j; const float* s = scr + (8 * c) * 33 + n;
        u32x4 o; o.x = pk2(s[0 * 33], s[1 * 33]); o.y = pk2(s[2 * 33], s[3 * 33]); o.z = pk2(s[4 * 33], s[5 * 33]); o.w = pk2(s[6 * 33], s[7 * 33]);
        *(u32x4*)(WT + (size_t)(dst_row0 + n) * K + k0 + 8 * c) = o; }
    asm volatile("s_waitcnt lgkmcnt(0)" ::: "memory");
}
__device__ __forceinline__ void phase0(const Args& a, unsigned char* lds, int gw, int NGW, int wave, int lane) {
    const float* w_in = a.in[4]; const float* b_in = a.in[5]; const float* w_a = a.in[9]; const float* w_b = a.in[10]; const float* w_out = a.in[11];
    bf16_t* W1T = (bf16_t*)(a.ws + WS_W1T); bf16_t* WAT = (bf16_t*)(a.ws + WS_WAT); bf16_t* WBT = (bf16_t*)(a.ws + WS_WBT); bf16_t* WOT = (bf16_t*)(a.ws + WS_WOT);
    float* scr = (float*)(lds + wave * 16384);
    constexpr int I_A = 144 * 16, I_MG = 64 * 16, I_G = 16, I_WA = 32 * 8, I_WB = 32 * 8, I_WO = 32 * 16, NITEMS = I_A + I_MG + I_G + I_WA + I_WB + I_WO;
    for (int it = gw; it < NITEMS; it += NGW) {
        int r = it;
        if (r < I_A) { p0_transpose_item(w_in, NIN, 1024, W1T, (r % 144) * 32, (r % 144) * 32, 32, (r / 144) * 64, scr, lane); continue; } r -= I_A;
        if (r < I_MG) { p0_transpose_item(w_in, NIN, 1024, W1T, 4624 + (r % 64) * 32, 4608 + (r % 64) * 32, 32, (r / 64) * 64, scr, lane); continue; } r -= I_MG;
        if (r < I_G) { p0_transpose_item(w_in, NIN, 1024, W1T, 4608, 6656, 16, r * 64, scr, lane); continue; } r -= I_G;
        if (r < I_WA) { p0_transpose_item(w_a, 1024, 512, WAT, (r % 32) * 32, (r % 32) * 32, 32, (r / 32) * 64, scr, lane); continue; } r -= I_WA;
        if (r < I_WB) { p0_transpose_item(w_b, 1024, 512, WBT, (r % 32) * 32, (r % 32) * 32, 32, (r / 32) * 64, scr, lane); continue; } r -= I_WB;
        p0_transpose_item(w_out, 1024, 1024, WOT, (r % 32) * 32, (r % 32) * 32, 32, (r / 32) * 64, scr, lane);
    }
    for (int i = gw * 64 + lane; i < (N1 - 6688) * 1024 / 8; i += NGW * 64) ((u32x4*)(W1T + (size_t)6688 * 1024))[i] = (u32x4){0u, 0u, 0u, 0u};
    float* bias1 = (float*)(a.ws + WS_BIAS1);
    for (int c = gw * 64 + lane; c < N1; c += NGW * 64) bias1[c] = c < 4608 ? b_in[c] : (c < 6656 ? b_in[4624 + (c - 4608)] : (c < 6672 ? b_in[4608 + (c - 6656)] : 0.f));
    const float* xp = a.in[0]; const float* xs = a.in[1]; const float* meta = a.in[2]; const float* g_pre = a.in[3];
    bf16_t* XN = (bf16_t*)((unsigned char*)a.out + DO_XN);
    f32x4 gv[4];
#pragma unroll
    for (int j = 0; j < 4; ++j) gv[j] = ((const f32x4*)g_pre)[lane + 64 * j];
    for (int m = gw; m < MPAD; m += NGW) {
        int b, p; row_info(m, b, p);
        unsigned long long* o8 = (unsigned long long*)(XN + (size_t)m * DM) + lane;
        if (b < 0 || p < 48) {
#pragma unroll
            for (int j = 0; j < 4; ++j) o8[64 * j] = 0ull;
            continue; }
        const float* src = p < 64 ? meta + (size_t)(p - 48) * DM : (b < NPROMPT ? xp + ((size_t)b * TP + (p - 64)) * DM : xs + ((size_t)(b - NPROMPT) * TS + (p - 64)) * DM);
        f32x4 v[4]; float s = 0.f;
#pragma unroll
        for (int j = 0; j < 4; ++j) { v[j] = ((const f32x4*)src)[lane + 64 * j]; s += (v[j].x * v[j].x + v[j].y * v[j].y) + (v[j].z * v[j].z + v[j].w * v[j].w); }
        const float rstd = rsqrtf(wave_sum(s) * (1.f / DM) + EPS);
#pragma unroll
        for (int j = 0; j < 4; ++j) { const f32x4 y = v[j] * rstd * gv[j]; o8[64 * j] = (unsigned long long)pk2(y.x, y.y) | ((unsigned long long)pk2(y.z, y.w) << 32); }
    }
}

__device__ __forceinline__ void na_phase_valu(const Args& a, unsigned char* lds, int gw, int NGW, int wave, int lane) {
    bf16_t* PROJ = (bf16_t*)(a.ws + WS_PROJ); const float* rpb = a.in[6];
    float* qs = (float*)(lds + wave * 1024); float* ps = qs + 64;
    for (int it = gw; it < MROWS * 8; it += NGW) {
        const int m = it >> 3, h = it & 7; int b, p; row_info(m, b, p);
        if (p < 48) continue;
        const int base = seq_base(b); const int rows = (b < NPROMPT ? TP : TS) / 64;
        const bf16_t* prow = PROJ + (size_t)m * LDP;
        qs[lane] = bf2f(prow[C_NAQ + h * 64 + lane]);
        int nkeys, r = 0, c = 0, r0 = 0, c0 = 0;
        if (p < 64) nkeys = 16; else { const int t = p - 64; r = t >> 6; c = t & 63; r0 = min(max(r - 4, 0), rows - 8); c0 = min(max(c - 8, 0), 48); nkeys = 144; }
        asm volatile("s_waitcnt lgkmcnt(0)" ::: "memory");
        float sc[3];
#pragma unroll
        for (int k3 = 0; k3 < 3; ++k3) { const int i = lane + 64 * k3; float s = -INFINITY;
            if (i < nkeys) { int krow; float bias = 0.f;
                if (i < 16) krow = base + 48 + i; else { const int w = (i - 16) >> 4, j = (i - 16) & 15; krow = base + 64 + (r0 + w) * 64 + c0 + j; bias = rpb[(h * 15 + (r0 + w - r + 7)) * 31 + (c0 + j - c + 15)]; }
                const u32x4* kp = (const u32x4*)(PROJ + (size_t)krow * LDP + C_NAK + h * 64); float d = 0.f;
#pragma unroll
                for (int q8 = 0; q8 < 8; ++q8) { const u32x4 kv = kp[q8]; const float* qq = qs + 8 * q8;
                    d += qq[0] * bf2f(kv.x & 0xffffu) + qq[1] * bf2f(kv.x >> 16) + qq[2] * bf2f(kv.y & 0xffffu) + qq[3] * bf2f(kv.y >> 16)
                       + qq[4] * bf2f(kv.z & 0xffffu) + qq[5] * bf2f(kv.z >> 16) + qq[6] * bf2f(kv.w & 0xffffu) + qq[7] * bf2f(kv.w >> 16); }
                s = d * 0.125f + bias; }
            sc[k3] = s; }
        const float mx = wave_max(fmaxf(sc[0], fmaxf(sc[1], sc[2])));
        float e0 = __expf(sc[0] - mx), e1 = __expf(sc[1] - mx), e2 = __expf(sc[2] - mx);
        const float sum = wave_sum(e0 + e1 + e2);
        ps[lane] = e0; ps[lane + 64] = e1; ps[lane + 128] = e2;
        asm volatile("s_waitcnt lgkmcnt(0)" ::: "memory");
        float o = 0.f;
        for (int i = 0; i < nkeys; ++i) { int krow;
            if (i < 16) krow = base + 48 + i; else { const int w = (i - 16) >> 4, j = (i - 16) & 15; krow = base + 64 + (r0 + w) * 64 + c0 + j; }
            o += ps[i] * bf2f(PROJ[(size_t)krow * LDP + C_NAV + h * 64 + lane]); }
        const float z = bf2f(prow[C_NAZ + h * 64 + lane]);
        ((bf16_t*)prow)[C_YA + h * 64 + lane] = (bf16_t)f2bf(o / sum * siluf_(z));
        asm volatile("s_waitcnt lgkmcnt(0)" ::: "memory");
    }
}

__device__ __forceinline__ void mlstm_phase_rec(const Args& a, unsigned char* lds, int tid) {
    const bf16_t* PROJ = (const bf16_t*)(a.ws + WS_PROJ); const float* GATES = (const float*)(a.ws + WS_GATES); const float* cw = a.in[7];
    float* L = (float*)lds;
    for (int sid = blockIdx.x; sid < 80; sid += gridDim.x) {
        const int dir = sid & 1, hd = (sid >> 1) & 3, b = 9 - (sid >> 3);
        const int base = seq_base(b), Lp = seq_lp(b), nreal = Lp - 48;
        bf16_t* H = (bf16_t*)((unsigned char*)a.out + (dir ? DO_HB : DO_HF));
        const int v = tid >> 2, kq = tid & 3;
        float C[32], nn[32];
#pragma unroll
        for (int i = 0; i < 32; ++i) { C[i] = 0.f; nn[i] = 0.f; }
        float mst = 0.f;
        int col = 0; float w0 = 0.f, w1 = 0.f, w2 = 0.f, kscale = 1.f;
        if (tid < 256) { const int ch = (tid < 128 ? 0 : 512) + hd * 128 + (tid & 127); col = (tid < 128 ? C_MLQ : C_MLK) + hd * 128 + (tid & 127); w0 = cw[ch]; w1 = cw[1024 + ch]; w2 = cw[2048 + ch]; kscale = tid < 128 ? 1.f : 0.08838834764831845f; }
        else if (tid < 384) col = C_MLV + hd * 128 + (tid - 256);
        float r0 = 0.f, r1 = 0.f, r2 = 0.f;
#define LOAD_RAW(s_) do { const int p_ = dir ? (Lp - 1 - (s_)) : (48 + (s_)); const size_t m_ = (size_t)(base + p_); \
            if (tid < 256) { r1 = bf2f(PROJ[m_ * LDP + col]); r0 = (p_ - 1 >= 48) ? bf2f(PROJ[(m_ - 1) * LDP + col]) : 0.f; r2 = (p_ + 1 < Lp) ? bf2f(PROJ[(m_ + 1) * LDP + col]) : 0.f; } \
            else if (tid < 384) r1 = bf2f(PROJ[m_ * LDP + col]); \
            else if (tid == 384) { r0 = GATES[m_ * 16 + (dir * 2) * 4 + hd]; r1 = GATES[m_ * 16 + (dir * 2 + 1) * 4 + hd]; } } while (0)
        LOAD_RAW(0);
        for (int s = 0; s < nreal; ++s) {
            float* Lb = L + (s & 1) * 512;
            if (tid < 256) { const float x = w0 * r0 + w1 * r1 + w2 * r2; Lb[tid] = siluf_(x) * kscale; }
            else if (tid < 384) Lb[tid] = r1;
            else if (tid == 384) { Lb[384] = r0; Lb[385] = fminf(r1, 0.f) - log1pf(__expf(-fabsf(r1))); }
            __syncthreads();
            if (s + 1 < nreal) LOAD_RAW(s + 1);
            const float ig = Lb[384], lf = Lb[385];
            const float mnew = fmaxf(lf + mst, ig), fs = __expf(lf + mst - mnew), is = __expf(ig - mnew); mst = mnew;
            const float vv = Lb[256 + v] * is; float num = 0.f, den = 0.f;
#pragma unroll
            for (int i = 0; i < 32; ++i) { const float kk = Lb[128 + 32 * kq + i], qq = Lb[32 * kq + i];
                C[i] = fs * C[i] + vv * kk; nn[i] = fs * nn[i] + is * kk; num += C[i] * qq; den += nn[i] * qq; }
            num += __shfl_xor(num, 1); num += __shfl_xor(num, 2); den += __shfl_xor(den, 1); den += __shfl_xor(den, 2);
            const float hval = num / fmaxf(fabsf(den), __expf(-mnew));
            const int p = dir ? (Lp - 1 - s) : (48 + s);
            if (kq == 0) H[(size_t)(base + p) * 512 + hd * 128 + v] = (bf16_t)f2bf(hval);
        }
        __syncthreads();
    }
}
__device__ __forceinline__ void mlstm_combine(const Args& a, int gw, int NGW, int lane) {
    bf16_t* PROJ = (bf16_t*)(a.ws + WS_PROJ); const float* head_g = a.in[8];
    const bf16_t* HF = (const bf16_t*)((unsigned char*)a.out + DO_HF); const bf16_t* HB = (const bf16_t*)((unsigned char*)a.out + DO_HB);
    for (int it = gw; it < MROWS * 4; it += NGW) {
        const int m = it >> 2, hd = it & 3; int b, p; row_info(m, b, p);
        if (p < 48) continue;
        const int cc = hd * 128 + 2 * lane;
        const unsigned f = *(const unsigned*)(HF + (size_t)m * 512 + cc), bb = *(const unsigned*)(HB + (size_t)m * 512 + cc);
        bf16_t* prow = PROJ + (size_t)m * LDP;
        const unsigned ov = *(const unsigned*)(prow + C_MLO + cc), zv = *(const unsigned*)(prow + C_MLZ + cc);
        const float h0 = (bf2f(f & 0xffffu) + bf2f(bb & 0xffffu)) * sigmoidf_(bf2f(ov & 0xffffu)), h1 = (bf2f(f >> 16) + bf2f(bb >> 16)) * sigmoidf_(bf2f(ov >> 16));
        const float mu = wave_sum(h0 + h1) * (1.f / 128.f); const float d0 = h0 - mu, d1 = h1 - mu;
        const float var = wave_sum(d0 * d0 + d1 * d1) * (1.f / 128.f); const float rs = rsqrtf(var + EPS);
        const float y0 = d0 * rs * head_g[cc] * siluf_(bf2f(zv & 0xffffu)), y1 = d1 * rs * head_g[cc + 1] * siluf_(bf2f(zv >> 16));
        *(unsigned*)(prow + C_YB + cc) = pk2(y0, y1);
    }
}
__device__ __forceinline__ void phase_out(const Args& a, int gw, int NGW, int lane) {
    const bf16_t* PROJ = (const bf16_t*)(a.ws + WS_PROJ); const float* SS = (const float*)(a.ws + WS_SS); const float* g_post = a.in[12];
    const float* xp = a.in[0]; const float* xs = a.in[1];
    f32x4 gv[4];
#pragma unroll
    for (int j = 0; j < 4; ++j) gv[j] = ((const f32x4*)g_post)[lane + 64 * j];
    for (int m = gw; m < MROWS; m += NGW) {
        int b, p; row_info(m, b, p);
        if (p < 64) continue;
        const size_t off = b < NPROMPT ? ((size_t)b * TP + (p - 64)) * DM : (size_t)NPROMPT * TP * DM + ((size_t)(b - NPROMPT) * TS + (p - 64)) * DM;
        const float* src = b < NPROMPT ? xp + off : xs + (off - (size_t)NPROMPT * TP * DM);
        float s = (lane < 16) ? SS[(size_t)m * 16 + lane] : 0.f; s = wave_sum(s);
        const float rstd = rsqrtf(s * (1.f / DM) + EPS);
        const u32x2* yr = (const u32x2*)(PROJ + (size_t)m * LDP + C_Y);
#pragma unroll
        for (int j = 0; j < 4; ++j) { const f32x4 xv = ((const f32x4*)src)[lane + 64 * j]; const u32x2 yv = yr[lane + 64 * j];
            f32x4 o; o.x = xv.x + bf2f(yv.x & 0xffffu) * rstd * gv[j].x; o.y = xv.y + bf2f(yv.x >> 16) * rstd * gv[j].y; o.z = xv.z + bf2f(yv.y & 0xffffu) * rstd * gv[j].z; o.w = xv.w + bf2f(yv.y >> 16) * rstd * gv[j].w;
            ((f32x4*)(a.out + off))[lane + 64 * j] = o; }
    }
}

constexpr int N_PHASES = 7;
#ifndef MK_N_LAUNCHES
#define MK_N_LAUNCHES 7
#endif
__global__ void __launch_bounds__(NTHREADS, 2) hybrid_fwd(Args args) {
    extern __shared__ __attribute__((aligned(16))) unsigned char lds[];
    const int tid = threadIdx.x, lane = tid & 63, wave = __builtin_amdgcn_readfirstlane(tid >> 6);
    const int G = gridDim.x, gw = blockIdx.x * NWAVES + wave, NGW = G * NWAVES;
    const int lo = args.ph_lo, hi = args.ph_hi;
    unsigned char* ws = args.ws;
    bf16_t* PROJ = (bf16_t*)(ws + WS_PROJ);
    unsigned char* mgq_lo = (unsigned char*)args.out + DO_MGQ_LO; unsigned char* mgq_hi = ws + WS_MGQ_HI;
#define IN(k) (lo <= (k) && (k) < hi)
#define SEAM(k) do { if (IN(k) && IN((k) + 1)) { __threadfence(); cg::this_grid().sync(); } } while (0)
    if (IN(0)) { phase0(args, lds, gw, NGW, wave, lane); }
    SEAM(0);
    if (IN(1)) {
        pg8::Gemm g{(const bf16_t*)((unsigned char*)args.out + DO_XN), (const bf16_t*)(ws + WS_W1T), MPAD, N1, 1024, 1024, 1024}; pg8::StaticOrder S; S.init(MPAD, N1, G, (int)blockIdx.x);
        pg8::EpiProj E{PROJ, mgq_lo, mgq_hi, (float*)(ws + WS_GATES), (const float*)(ws + WS_BIAS1)};
        pg8::gemm_phase<pg8::EpiProj, pg8::StaticOrder, true, true>((PG8_LAS unsigned char*)lds, g, S, E);
    }
    SEAM(1);
    if (IN(2)) { mlstm_phase_rec(args, lds, tid); __syncthreads(); na_phase_valu(args, lds, gw, NGW, wave, lane); }
    SEAM(2);
    if (IN(3)) { mlstm_combine(args, gw, NGW, lane); }
    SEAM(3);
    if (IN(4)) {
        pg8::StaticOrder S; S.init(MPAD, 1024, G, (int)blockIdx.x);
        { pg8::Gemm g{PROJ + C_YA, (const bf16_t*)(ws + WS_WAT), MPAD, 1024, 512, LDP, 512}; pg8::EpiMix<false> E{PROJ + C_MIX, mgq_lo, mgq_hi};
          pg8::gemm_phase<pg8::EpiMix<false>, pg8::StaticOrder, true, true>((PG8_LAS unsigned char*)lds, g, S, E); }
        __syncthreads();
        { pg8::Gemm g{PROJ + C_YB, (const bf16_t*)(ws + WS_WBT), MPAD, 1024, 512, LDP, 512}; pg8::EpiMix<true> E{PROJ + C_MIX, mgq_lo, mgq_hi};
          pg8::gemm_phase<pg8::EpiMix<true>, pg8::StaticOrder, true, true>((PG8_LAS unsigned char*)lds, g, S, E); }
    }
    SEAM(4);
    if (IN(5)) {
        pg8::Gemm g{PROJ + C_MIX, (const bf16_t*)(ws + WS_WOT), MPAD, 1024, 1024, LDP, 1024}; pg8::StaticOrder S; S.init(MPAD, 1024, G, (int)blockIdx.x);
        pg8::EpiY E{PROJ + C_Y, (float*)(ws + WS_SS)};
        pg8::gemm_phase<pg8::EpiY, pg8::StaticOrder, true, true>((PG8_LAS unsigned char*)lds, g, S, E);
    }
    SEAM(5);
    if (IN(6)) { phase_out(args, gw, NGW, lane); }
#undef IN
#undef SEAM
}

extern "C" void kernel_launch(void* const* d_in, const int* in_sizes, int n_in, void* d_out, int out_size, void* d_ws, size_t ws_size, hipStream_t stream) {
    static int grid = 0;
    if (grid == 0) {
        if (n_in != 13 || out_size != 49152 * 1024 || ws_size < WS_END) { fprintf(stderr, "kernel_launch: unexpected shapes (n_in %d, out %d, ws %zu, need %zu)\n", n_in, out_size, ws_size, (size_t)WS_END); grid = -1; return; }
        int dev = 0, cus = 0, per_cu = 0;
        hipGetDevice(&dev); hipDeviceGetAttribute(&cus, hipDeviceAttributeMultiprocessorCount, dev);
        if (hipFuncSetAttribute((const void*)hybrid_fwd, hipFuncAttributeMaxDynamicSharedMemorySize, LDS_BYTES) != hipSuccess) { fprintf(stderr, "kernel_launch: hipFuncSetAttribute failed\n"); grid = -1; return; }
        if (hipOccupancyMaxActiveBlocksPerMultiprocessor(&per_cu, (const void*)hybrid_fwd, NTHREADS, LDS_BYTES) != hipSuccess || per_cu < 1) { fprintf(stderr, "kernel_launch: occupancy query says %d\n", per_cu); per_cu = 1; }
        (void)hipGetLastError();
        grid = cus;
    }
    if (grid < 0) return;
    Args a{};
    for (int i = 0; i < 13; ++i) a.in[i] = (const float*)d_in[i];
    a.out = (float*)d_out; a.ws = (unsigned char*)d_ws;
    if (MK_N_LAUNCHES == 1) {
        a.ph_lo = 0; a.ph_hi = N_PHASES; a.coop = 1;
        void* kargs[] = {&a};
        hipError_t e = hipLaunchCooperativeKernel((const void*)hybrid_fwd, dim3(grid), dim3(NTHREADS), kargs, LDS_BYTES, stream);
        if (e != hipSuccess) fprintf(stderr, "cooperative launch failed: %s (grid %d)\n", hipGetErrorString(e), grid);
    } else {
        for (int ph = 0; ph < N_PHASES; ++ph) { a.ph_lo = ph; a.ph_hi = ph + 1; a.coop = 0;
            hipLaunchKernelGGL(hybrid_fwd, dim3(grid), dim3(NTHREADS), LDS_BYTES, stream, a); }
    }
}
```

```cpp
#include <hip/hip_runtime.h>
#include <hip/hip_cooperative_groups.h>
#include <cstdio>
#include <cstdint>
namespace cg = cooperative_groups;
namespace pg8 {
#define PG8_LAS __attribute__((address_space(3)))
typedef unsigned short bf16_t;
typedef short bf16x8 __attribute__((ext_vector_type(8)));
typedef float f32x4 __attribute__((ext_vector_type(4)));
typedef unsigned u32x4 __attribute__((ext_vector_type(4)));
constexpr int BM = 256, BK = 64, HALF = 128, HTB = HALF * BK * 2  , NXCD = 8, WGM = 8;

__host__ __device__ __forceinline__ int lds_byte(int r, int c) { const int st = (r >> 4) * 2 + (c >> 5), rr = r & 15, cc = c & 31, ob = rr * 64 + cc * 2; return st * 1024 + (ob ^ (((ob >> 9) & 1) << 5)); }
__host__ __device__ __forceinline__ void stage_rc(int b, int& R, int& C) { const int st = b / 1024, sb = b % 1024, swz = sb ^ (((sb >> 9) & 1) << 5); R = (st >> 1) * 16 + swz / 64; C = (st & 1) * 32 + (swz % 64) / 2; }
__host__ __device__ __forceinline__ int perm32(int rho) { const int n = rho >> 4, i = rho & 15; return 8 * (i >> 2) + 4 * n + (i & 3); }

struct Unit { int pm, pn; };
struct Gemm { const bf16_t* A; const bf16_t* Bt; int M, N, K, lda, ldb, tok; };
__host__ __device__ __forceinline__ int tok_tile_row(int pm) { const int b = pm < 128 ? (pm >> 4) : 8 + ((pm - 128) >> 5); return pm * 256 + 64 * (b + 1); }
__host__ __device__ __forceinline__ size_t a_tile_row(const Gemm& g, int pm) { return (size_t)(g.tok ? tok_tile_row(pm) : pm * 256); }

struct StaticOrder {
    int nM, nN, nwg, G, c;
    __host__ __device__ void init(int M, int N, int G_, int c_) { nM = M / BM; nN = N / BM; nwg = nM * nN; G = G_; c = c_; }
    __host__ __device__ bool next(int i, Unit& u) const {
        const long L = (long)i * G + c; if (L >= nwg) return false;
        int wgid = (int)L; { const int q = nwg / NXCD, r = nwg % NXCD, xcd = wgid % NXCD, off = wgid / NXCD; wgid = (xcd < r ? xcd * (q + 1) : r * (q + 1) + (xcd - r) * q) + off; }
        const int nig = WGM * nN, gid = wgid / nig, fm = gid * WGM, gsz = (nM - fm) < WGM ? (nM - fm) : WGM;
        u.pm = fm + ((wgid % nig) % gsz); u.pn = (wgid % nig) / gsz; return true;
    }
    __device__ __forceinline__ void a_ready(const Unit&) const {}
    __device__ __forceinline__ void done(const Unit&) const {}
};

__device__ __forceinline__ unsigned cvt_pk_bf16(float lo, float hi) { unsigned r; asm volatile("v_cvt_pk_bf16_f32 %0, %1, %2" : "=v"(r) : "v"(lo), "v"(hi)); return r; }
typedef unsigned u32x2 __attribute__((ext_vector_type(2)));
__device__ __forceinline__ float bf2f(unsigned u16) { return __uint_as_float(u16 << 16); }
__device__ __forceinline__ float sigmoidf_(float x) { return __builtin_amdgcn_rcpf(1.0f + __builtin_amdgcn_exp2f(x * -1.4426950408889634f)); }
constexpr int P1_NT_PROJ = 18, P1_NT_MG = 8;
constexpr int LDP = 4608;
constexpr int MGQ_SPLIT_ROW = 48384;

struct EpiProj {
    static constexpr bool PERM = true, AFTER_DRAIN = false;
    bf16_t* proj; unsigned char* mgq_lo; unsigned char* mgq_hi; float* gates; const float* bias; bf16_t* halo;
    __device__ __forceinline__ void operator()(const f32x4 (&acc)[2][2][4][2], const Unit& u, int wr, int wc, int fr, int fq) const {
        const int row0 = u.pm * BM + wr * 64 + fr; const int cl = wc * 32 + 8 * fq; const int bcol0 = u.pn * BM + cl;
        f32x4 bv[2][2];
#pragma unroll
        for (int bj = 0; bj < 2; ++bj)
#pragma unroll
            for (int n = 0; n < 2; ++n) bv[bj][n] = *(const f32x4*)(bias + bcol0 + bj * HALF + 4 * n);
        if (u.pn < P1_NT_PROJ) {
#pragma unroll
            for (int ai = 0; ai < 2; ++ai)
#pragma unroll
                for (int m = 0; m < 4; ++m) { bf16_t* rowp = proj + (size_t)(row0 + ai * HALF + m * 16) * LDP + bcol0;
#pragma unroll
                    for (int bj = 0; bj < 2; ++bj) { const f32x4 v0 = acc[ai][bj][m][0] + bv[bj][0], v1 = acc[ai][bj][m][1] + bv[bj][1];
                        u32x4 w; w.x = cvt_pk_bf16(v0[0], v0[1]); w.y = cvt_pk_bf16(v0[2], v0[3]); w.z = cvt_pk_bf16(v1[0], v1[1]); w.w = cvt_pk_bf16(v1[2], v1[3]);
                        *(u32x4*)(rowp + bj * HALF) = w;
                        if (u.pn >= 8 && u.pn < 12 && ((m == 0 && fr == 0) || (m == 3 && fr == 15)))
                            *(u32x4*)(halo + ((size_t)((row0 + ai * HALF + m * 16) >> 6) * 2 + (m == 3 ? 1 : 0)) * 1024 + (u.pn - 8) * BM + cl + bj * HALF) = w; } }
        } else if (u.pn < P1_NT_PROJ + P1_NT_MG) {
            const int gc0 = (u.pn - P1_NT_PROJ) * BM + cl;
#pragma unroll
            for (int ai = 0; ai < 2; ++ai)
#pragma unroll
                for (int m = 0; m < 4; ++m) { const int row = row0 + ai * HALF + m * 16;
                    unsigned char* rowp = (row < MGQ_SPLIT_ROW ? mgq_lo + (size_t)row * 2048 : mgq_hi + (size_t)(row - MGQ_SPLIT_ROW) * 2048) + gc0;
#pragma unroll
                    for (int bj = 0; bj < 2; ++bj) { const f32x4 v0 = acc[ai][bj][m][0] + bv[bj][0], v1 = acc[ai][bj][m][1] + bv[bj][1];
                        u32x2 w; w.x = 0u; w.y = 0u;
                        w.x = __builtin_amdgcn_cvt_pk_u8_f32(sigmoidf_(v0[0]) * 255.0f, 0, w.x); w.x = __builtin_amdgcn_cvt_pk_u8_f32(sigmoidf_(v0[1]) * 255.0f, 1, w.x);
                        w.x = __builtin_amdgcn_cvt_pk_u8_f32(sigmoidf_(v0[2]) * 255.0f, 2, w.x); w.x = __builtin_amdgcn_cvt_pk_u8_f32(sigmoidf_(v0[3]) * 255.0f, 3, w.x);
                        w.y = __builtin_amdgcn_cvt_pk_u8_f32(sigmoidf_(v1[0]) * 255.0f, 0, w.y); w.y = __builtin_amdgcn_cvt_pk_u8_f32(sigmoidf_(v1[1]) * 255.0f, 1, w.y);
                        w.y = __builtin_amdgcn_cvt_pk_u8_f32(sigmoidf_(v1[2]) * 255.0f, 2, w.y); w.y = __builtin_amdgcn_cvt_pk_u8_f32(sigmoidf_(v1[3]) * 255.0f, 3, w.y);
                        *(u32x2*)(rowp + bj * HALF) = w; } }
        } else {
            if (wc == 0 && fq < 2) {
#pragma unroll
                for (int ai = 0; ai < 2; ++ai)
#pragma unroll
                    for (int m = 0; m < 4; ++m) { float* gp = gates + (size_t)(row0 + ai * HALF + m * 16) * 16 + 8 * fq;
                        *(f32x4*)(gp) = acc[ai][0][m][0] + bv[0][0]; *(f32x4*)(gp + 4) = acc[ai][0][m][1] + bv[0][1]; }
            }
        }
    }
};
__device__ __forceinline__ const unsigned char* mgq_row(const unsigned char* lo, const unsigned char* hi, int row) { return row < MGQ_SPLIT_ROW ? lo + (size_t)row * 2048 : hi + (size_t)(row - MGQ_SPLIT_ROW) * 2048; }
template <bool SECOND> struct EpiMix {
    static constexpr bool PERM = true, AFTER_DRAIN = false;
    bf16_t* mix; const unsigned char* mgq_lo; const unsigned char* mgq_hi;
    __device__ __forceinline__ void operator()(const f32x4 (&acc)[2][2][4][2], const Unit& u, int wr, int wc, int fr, int fq) const {
        const int row0 = u.pm * BM + wr * 64 + fr; const int col0 = u.pn * BM + wc * 32 + 8 * fq;
#pragma unroll
        for (int ai = 0; ai < 2; ++ai)
#pragma unroll
            for (int m = 0; m < 4; ++m) { const int row = row0 + ai * HALF + m * 16; bf16_t* rowp = mix + (size_t)row * LDP + col0;
                const unsigned char* gp = mgq_row(mgq_lo, mgq_hi, row + tok_tile_row(u.pm) - u.pm * BM) + (SECOND ? 1024 : 0) + col0;
#pragma unroll
                for (int bj = 0; bj < 2; ++bj) { const u32x2 gq = *(const u32x2*)(gp + bj * HALF); float g[8];
#pragma unroll
                    for (int e = 0; e < 4; ++e) { g[e] = (float)((gq.x >> (8 * e)) & 255u) * (1.0f / 255.0f); g[4 + e] = (float)((gq.y >> (8 * e)) & 255u) * (1.0f / 255.0f); }
                    float v[8];
#pragma unroll
                    for (int e = 0; e < 4; ++e) { v[e] = acc[ai][bj][m][0][e] * g[e]; v[4 + e] = acc[ai][bj][m][1][e] * g[4 + e]; }
                    if (SECOND) { const u32x4 old = *(const u32x4*)(rowp + bj * HALF);
                        v[0] += bf2f(old.x & 0xffffu); v[1] += bf2f(old.x >> 16); v[2] += bf2f(old.y & 0xffffu); v[3] += bf2f(old.y >> 16);
                        v[4] += bf2f(old.z & 0xffffu); v[5] += bf2f(old.z >> 16); v[6] += bf2f(old.w & 0xffffu); v[7] += bf2f(old.w >> 16); }
                    u32x4 w; w.x = cvt_pk_bf16(v[0], v[1]); w.y = cvt_pk_bf16(v[2], v[3]); w.z = cvt_pk_bf16(v[4], v[5]); w.w = cvt_pk_bf16(v[6], v[7]);
                    *(u32x4*)(rowp + bj * HALF) = w; } }
    }
};
struct EpiY {
    static constexpr bool PERM = true, AFTER_DRAIN = false;
    bf16_t* y; float* ss;
    __device__ __forceinline__ void operator()(const f32x4 (&acc)[2][2][4][2], const Unit& u, int wr, int wc, int fr, int fq) const {
        const int row0 = u.pm * BM + wr * 64 + fr; const int col0 = u.pn * BM + wc * 32 + 8 * fq;
#pragma unroll
        for (int ai = 0; ai < 2; ++ai)
#pragma unroll
            for (int m = 0; m < 4; ++m) { const int row = row0 + ai * HALF + m * 16; bf16_t* rowp = y + (size_t)row * LDP + col0; float s = 0.f;
#pragma unroll
                for (int bj = 0; bj < 2; ++bj) { const f32x4 v0 = acc[ai][bj][m][0], v1 = acc[ai][bj][m][1];
                    s += (v0[0] * v0[0] + v0[1] * v0[1]) + (v0[2] * v0[2] + v0[3] * v0[3]) + (v1[0] * v1[0] + v1[1] * v1[1]) + (v1[2] * v1[2] + v1[3] * v1[3]);
                    u32x4 w; w.x = cvt_pk_bf16(v0[0], v0[1]); w.y = cvt_pk_bf16(v0[2], v0[3]); w.z = cvt_pk_bf16(v1[0], v1[1]); w.w = cvt_pk_bf16(v1[2], v1[3]);
                    *(u32x4*)(rowp + bj * HALF) = w; }
                s += __shfl_xor(s, 16); s += __shfl_xor(s, 32);
                if (fq == 0) ss[(size_t)row * 16 + u.pn * 4 + wc] = s; }
    }
};
template <class Epi, class Sched, bool ALIGN_EPI = false, bool SP2 = false>
__device__ __forceinline__ void gemm_phase(PG8_LAS unsigned char* lds, const Gemm g, const Sched& S, const Epi& E) {
    const int tid = threadIdx.x, wid = __builtin_amdgcn_readfirstlane(tid >> 6), lane = tid & 63, wr = wid >> 2, wc = wid & 3, fr = lane & 15, fq = lane >> 4;
    const int K = g.K, nt = K / BK;
    unsigned voffA[2], voffB[2];
#pragma unroll
    for (int i = 0; i < 2; ++i) { int R, C; stage_rc(tid * 16 + i * 8192, R, C); const int Rb = Epi::PERM ? ((R & ~31) + perm32(R & 31)) : R;
        voffA[i] = (unsigned)(R * g.lda + C) * 2u; voffB[i] = (unsigned)(Rb * g.ldb + C) * 2u; }
    const size_t kstep = (size_t)(BK * 2);
    const size_t hstepA = (size_t)HALF * g.lda * 2, hstepB = (size_t)HALF * g.ldb * 2;
    const size_t tstepB = 2 * hstepB;
    const unsigned ldsw = (unsigned)wid * 1024u;
    const int aoff = lds_byte(wr * 64 + fr, fq * 8), boff = lds_byte(wc * 32 + fr, fq * 8);
#define PG8_SA(b, h) (((b) * 2 + (h)) * HTB)
#define PG8_SB(b, h) ((4 + (b) * 2 + (h)) * HTB)
#define PG8_STAGE(bufoff, gbase, voff) do { _Pragma("unroll") for (int _i = 0; _i < 2; ++_i) \
        __builtin_amdgcn_global_load_lds((const unsigned*)((const char*)(gbase) + (voff)[_i]), (PG8_LAS unsigned*)(lds + (bufoff) + ldsw + _i * 8192), 16, 0, 0); } while (0)
#define PG8_LDA(dst, b, h) do { _Pragma("unroll") for (int m = 0; m < 4; ++m) _Pragma("unroll") for (int k = 0; k < 2; ++k) dst[m][k] = *(const PG8_LAS bf16x8*)(lds + PG8_SA(b, h) + aoff + m * 2048 + k * 1024); } while (0)
#define PG8_LDB(dst, b, h) do { _Pragma("unroll") for (int n = 0; n < 2; ++n) _Pragma("unroll") for (int k = 0; k < 2; ++k) dst[n][k] = *(const PG8_LAS bf16x8*)(lds + PG8_SB(b, h) + boff + n * 2048 + k * 1024); } while (0)
#define PG8_MMA(ai, bj, At, Bt) do { __builtin_amdgcn_s_setprio(1); _Pragma("unroll") for (int m = 0; m < 4; ++m) _Pragma("unroll") for (int n = 0; n < 2; ++n) _Pragma("unroll") for (int k = 0; k < 2; ++k) \
        acc[ai][bj][m][n] = __builtin_amdgcn_mfma_f32_16x16x32_bf16(Bt[n][k], At[m][k], acc[ai][bj][m][n], 0, 0, 0); __builtin_amdgcn_s_setprio(0); } while (0)
#define PG8_WAIT_V(n) asm volatile("s_waitcnt vmcnt(" #n ")" ::: "memory")
#define PG8_WAIT_L(n) asm volatile("s_waitcnt lgkmcnt(" #n ")" ::: "memory")
#define PG8_BAR __builtin_amdgcn_s_barrier()
#define PG8_SCHED __builtin_amdgcn_sched_barrier(0)
    Unit cur, nxt; int ui = 0;
    if (!S.next(0, cur)) return;
    f32x4 acc[2][2][4][2];
#pragma unroll
    for (int a = 0; a < 2; ++a)
#pragma unroll
        for (int b = 0; b < 2; ++b)
#pragma unroll
            for (int m = 0; m < 4; ++m)
#pragma unroll
                for (int n = 0; n < 2; ++n) acc[a][b][m][n] = (f32x4){0.f, 0.f, 0.f, 0.f};
    bf16x8 At[4][2], B0[2][2], B1[2][2];
    const char* cA = (const char*)g.A + a_tile_row(g, cur.pm) * (size_t)g.lda * 2; const char* cB = (const char*)g.Bt + (size_t)cur.pn * tstepB;
    S.a_ready(cur);
    if constexpr (SP2) {
        PG8_STAGE(PG8_SB(0, 0), cB, voffB); PG8_STAGE(PG8_SB(0, 1), cB + hstepB, voffB); PG8_STAGE(PG8_SA(0, 0), cA, voffA); PG8_STAGE(PG8_SA(0, 1), cA + hstepA, voffA);
        if (wr == 1) PG8_BAR;
        PG8_WAIT_V(2); PG8_BAR;
        PG8_STAGE(PG8_SB(1, 0), cB + kstep, voffB); PG8_STAGE(PG8_SA(1, 0), cA + kstep, voffA); PG8_STAGE(PG8_SB(1, 1), cB + hstepB + kstep, voffB);
        PG8_WAIT_V(6); PG8_BAR;
    } else {
        PG8_STAGE(PG8_SB(0, 0), cB, voffB); PG8_STAGE(PG8_SA(0, 0), cA, voffA); PG8_STAGE(PG8_SB(0, 1), cB + hstepB, voffB); PG8_STAGE(PG8_SA(0, 1), cA + hstepA, voffA);
        if (wr == 1) PG8_BAR;
        PG8_WAIT_V(4); PG8_BAR;
        PG8_STAGE(PG8_SB(1, 0), cB + kstep, voffB); PG8_STAGE(PG8_SA(1, 0), cA + kstep, voffA); PG8_STAGE(PG8_SB(1, 1), cB + hstepB + kstep, voffB);
        PG8_WAIT_V(6); PG8_BAR;
    }
    for (;;) {
        const bool has_next = S.next(ui + 1, nxt);
        const char* nA = has_next ? (const char*)g.A + a_tile_row(g, nxt.pm) * (size_t)g.lda * 2 : cA; const char* nB = has_next ? (const char*)g.Bt + (size_t)nxt.pn * tstepB : cB;
        for (int t = 0; t < nt; t += 2) {
            const bool last = (t == nt - 2);
            const char* a1 = cA + (size_t)(t + 1) * kstep;
            const char* a2 = last ? nA : cA + (size_t)(t + 2) * kstep; const char* b2 = last ? nB : cB + (size_t)(t + 2) * kstep;
            const char* a3 = a2 + kstep; const char* b3 = b2 + kstep;
            if (last && has_next) S.a_ready(nxt);
            if constexpr (SP2) {
            PG8_LDB(B0, 0, 0); PG8_LDB(B1, 0, 1); PG8_SCHED; PG8_LDA(At, 0, 0); PG8_STAGE(PG8_SA(1, 1), a1 + hstepA, voffA);
            PG8_WAIT_V(8); PG8_WAIT_L(0); PG8_BAR; PG8_MMA(0, 0, At, B0); PG8_MMA(0, 1, At, B1); PG8_BAR; PG8_SCHED;
            PG8_LDA(At, 0, 1); PG8_STAGE(PG8_SB(0, 0), b2, voffB); PG8_STAGE(PG8_SB(0, 1), b2 + hstepB, voffB); PG8_STAGE(PG8_SA(0, 0), a2, voffA);
            PG8_WAIT_V(8); PG8_WAIT_L(0); PG8_BAR; PG8_MMA(1, 0, At, B0); PG8_MMA(1, 1, At, B1); PG8_BAR; PG8_SCHED;
            PG8_LDB(B0, 1, 0); PG8_LDB(B1, 1, 1); PG8_SCHED; PG8_LDA(At, 1, 0); PG8_STAGE(PG8_SA(0, 1), a2 + hstepA, voffA);
            PG8_WAIT_V(8); PG8_WAIT_L(0); PG8_BAR; PG8_MMA(0, 0, At, B0); PG8_MMA(0, 1, At, B1); PG8_BAR; PG8_SCHED;
            PG8_LDA(At, 1, 1); PG8_STAGE(PG8_SB(1, 0), b3, voffB); PG8_STAGE(PG8_SB(1, 1), b3 + hstepB, voffB); PG8_STAGE(PG8_SA(1, 0), a3, voffA);
            PG8_WAIT_V(8); PG8_WAIT_L(0); PG8_BAR; PG8_MMA(1, 0, At, B0); PG8_MMA(1, 1, At, B1); PG8_BAR; PG8_SCHED;
            } else {
            PG8_LDB(B0, 0, 0); PG8_SCHED; PG8_LDA(At, 0, 0); PG8_STAGE(PG8_SA(1, 1), a1 + hstepA, voffA);
            PG8_WAIT_L(8); PG8_BAR; PG8_WAIT_L(0); PG8_MMA(0, 0, At, B0); PG8_BAR; PG8_SCHED;
            PG8_LDB(B1, 0, 1); PG8_STAGE(PG8_SB(0, 0), b2, voffB);
            PG8_BAR; PG8_WAIT_L(0); PG8_MMA(0, 1, At, B1); PG8_BAR;
            PG8_LDA(At, 0, 1); PG8_STAGE(PG8_SA(0, 0), a2, voffA);
            PG8_BAR; PG8_WAIT_L(0); PG8_MMA(1, 0, At, B0); PG8_BAR; PG8_SCHED;
            PG8_STAGE(PG8_SB(0, 1), b2 + hstepB, voffB);
            PG8_WAIT_V(6); PG8_BAR; PG8_MMA(1, 1, At, B1); PG8_BAR;
            PG8_LDB(B0, 1, 0); PG8_SCHED; PG8_LDA(At, 1, 0); PG8_STAGE(PG8_SA(0, 1), a2 + hstepA, voffA);
            PG8_WAIT_L(8); PG8_BAR; PG8_WAIT_L(0); PG8_MMA(0, 0, At, B0); PG8_BAR; PG8_SCHED;
            PG8_LDB(B1, 1, 1); PG8_STAGE(PG8_SB(1, 0), b3, voffB);
            PG8_BAR; PG8_WAIT_L(0); PG8_MMA(0, 1, At, B1); PG8_BAR;
            PG8_LDA(At, 1, 1); PG8_STAGE(PG8_SA(1, 0), a3, voffA);
            PG8_BAR; PG8_WAIT_L(0); PG8_MMA(1, 0, At, B0); PG8_BAR; PG8_SCHED;
            PG8_STAGE(PG8_SB(1, 1), b3 + hstepB, voffB);
            PG8_WAIT_V(6); PG8_BAR; PG8_MMA(1, 1, At, B1); PG8_BAR;
            }
        }
        if constexpr (ALIGN_EPI) { if (wr == 0) PG8_BAR; }
        if constexpr (!Epi::AFTER_DRAIN) { E(acc, cur, wr, wc, fr, fq); S.done(cur); }
        if (!has_next) break;
#pragma unroll
        for (int a = 0; a < 2; ++a)
#pragma unroll
            for (int b = 0; b < 2; ++b)
#pragma unroll
                for (int m = 0; m < 4; ++m)
#pragma unroll
                    for (int n = 0; n < 2; ++n) acc[a][b][m][n] = (f32x4){0.f, 0.f, 0.f, 0.f};
        cur = nxt; cA = nA; cB = nB; ++ui;
        if constexpr (ALIGN_EPI) { if (wr == 1) PG8_BAR; }
    }
    PG8_WAIT_V(0);
    if constexpr (!ALIGN_EPI) { if (wr == 0) PG8_BAR; }
    PG8_BAR;
    if constexpr (Epi::AFTER_DRAIN) { E.fused(acc, cur, wr, wc, fr, fq, lds, wid, lane); S.done(cur); }
#undef PG8_SA
#undef PG8_SB
#undef PG8_STAGE
#undef PG8_LDA
#undef PG8_LDB
#undef PG8_MMA
#undef PG8_WAIT_V
#undef PG8_WAIT_L
#undef PG8_BAR
#undef PG8_SCHED
}
}
using pg8::bf16_t; using pg8::LDP; using pg8::bf2f; using pg8::sigmoidf_;
typedef float f32x4 __attribute__((ext_vector_type(4)));
typedef unsigned u32x4 __attribute__((ext_vector_type(4)));
typedef unsigned u32x2 __attribute__((ext_vector_type(2)));
typedef short bf16x8 __attribute__((ext_vector_type(8)));
#define LAS __attribute__((address_space(3)))
#define LDS_BARRIER() do { asm volatile("s_waitcnt lgkmcnt(0)" ::: "memory"); __builtin_amdgcn_s_barrier(); asm volatile("" ::: "memory"); } while (0)
constexpr int NWAVES = 8, NTHREADS = 512;
constexpr int DM = 1024, NPROMPT = 8, TP = 4096, TS = 8192, LPP = 4160, LPS = 8256;
constexpr int ROWS_P = NPROMPT * LPP;
constexpr int MROWS = ROWS_P + 2 * LPS;
constexpr int MPAD = 49920;
constexpr int NTOK = 49152;
constexpr int NIN = 6672, N1 = 6912;
constexpr int C_NAQ = 0, C_NAK = 512, C_NAV = 1024, C_NAZ = 1536, C_MLQ = 2048, C_MLK = 2560, C_MLV = 3072, C_MLZ = 3584, C_MLO = 4096;
constexpr int C_YA = 0, C_YB = 3072, C_MIX = 2048, C_Y = 1024;
constexpr float EPS = 1e-6f;
constexpr size_t MiB = 1u << 20;
constexpr size_t WS_W1T = 2 * MiB;
constexpr size_t WS_WAT = 16 * MiB, WS_WBT = 17 * MiB, WS_WOT = 18 * MiB;
constexpr size_t WS_BIAS1 = 20 * MiB;
constexpr size_t WS_GATES = 21 * MiB;
constexpr size_t WS_SS = 25 * MiB;
constexpr size_t WS_HALO = 28 * MiB + 512 * 1024;
constexpr size_t WS_PROJ = 32 * MiB;
constexpr size_t WS_MGQ_HI = WS_PROJ + (size_t)MPAD * LDP * 2;
constexpr size_t WS_MGQ_END = WS_MGQ_HI + (size_t)(MPAD - pg8::MGQ_SPLIT_ROW) * 2048;
constexpr size_t WS_SEGX = 474 * MiB, WS_START = 486 * MiB;
constexpr size_t WS_SEGN = 498 * MiB, WS_STARTN = 498 * MiB + 512 * 1024;
constexpr size_t WS_MLROWS = 499 * MiB;
constexpr size_t WS_END = WS_MLROWS + (size_t)MROWS * 32 * 4;
static_assert(WS_MGQ_END <= WS_SEGX && WS_END <= 512 * MiB, "d_ws map");
constexpr size_t DO_XN = 0, DO_HF = 0, DO_HB = (size_t)MPAD * 512 * 2, DO_MGQ_LO = (size_t)MPAD * 1024 * 2;
static_assert(DO_MGQ_LO + (size_t)pg8::MGQ_SPLIT_ROW * 2048 <= (size_t)49152 * 1024 * 4, "d_out map");
constexpr int LDS_BYTES = 163840;
constexpr size_t WS_BAR = 65536;
constexpr size_t WS_SEGCNT = 8192;
constexpr size_t WS_CTL_ZERO = 131072;
constexpr int LDS_BARST = LDS_BYTES - 64;

struct Args { const float* in[13]; float* out; unsigned char* ws; int ph_lo, ph_hi, coop, pad; };

__device__ __forceinline__ unsigned f2bf(float f) { unsigned u = __float_as_uint(f); return (u + 0x7fffu + ((u >> 16) & 1u)) >> 16; }
typedef __bf16 bf16v2_t __attribute__((ext_vector_type(2)));
typedef float f32v2_t __attribute__((ext_vector_type(2)));
__device__ __forceinline__ unsigned pk2(float lo, float hi) { const f32v2_t v = {lo, hi}; const bf16v2_t b = __builtin_convertvector(v, bf16v2_t); return __builtin_bit_cast(unsigned, b); }
__device__ __forceinline__ float siluf_(float x) { return x * __builtin_amdgcn_rcpf(1.0f + __expf(-x)); }
__device__ __forceinline__ float wave_sum(float v) {
#pragma unroll
    for (int o = 1; o < 64; o <<= 1) v += __shfl_xor(v, o);
    return v;
}
__device__ __forceinline__ float wave_max(float v) {
#pragma unroll
    for (int o = 1; o < 64; o <<= 1) v = fmaxf(v, __shfl_xor(v, o));
    return v;
}
__device__ __forceinline__ void row_info(int m, int& b, int& p) {
    if (m < ROWS_P) { b = m / LPP; p = m - b * LPP; }
    else if (m < MROWS) { const int r = m - ROWS_P; const int bb = r / LPS; b = NPROMPT + bb; p = r - bb * LPS; }
    else { b = -1; p = 0; }
}
__device__ __forceinline__ int seq_base(int b) { return b < NPROMPT ? b * LPP : ROWS_P + (b - NPROMPT) * LPS; }
__device__ __forceinline__ int seq_lp(int b) { return b < NPROMPT ? LPP : LPS; }

__device__ __forceinline__ void p0_transpose_item(const float* W, int Nsrc, int K, bf16_t* WT, int src_n0, int dst_row0, int nvalid, int k0, float* scr, int lane) {
#pragma unroll 8
    for (int i = 0; i < 32; ++i) { const int kk = 2 * i + (lane >> 5), n = lane & 31; scr[kk * 33 + n] = (n < nvalid) ? W[(size_t)(k0 + kk) * Nsrc + src_n0 + n] : 0.f; }
    asm volatile("s_waitcnt lgkmcnt(0)" ::: "memory");
    const int c = lane & 7;
#pragma unroll
    for (int j = 0; j < 4; ++j) { const int n = (lane >> 3) + 8 * j; const float* s = scr + (8 * c) * 33 + n;
        u32x4 o; o.x = pk2(s[0 * 33], s[1 * 33]); o.y = pk2(s[2 * 33], s[3 * 33]); o.z = pk2(s[4 * 33], s[5 * 33]); o.w = pk2(s[6 * 33], s[7 * 33]);
        *(u32x4*)(WT + (size_t)(dst_row0 + n) * K + k0 + 8 * c) = o; }
    asm volatile("s_waitcnt lgkmcnt(0)" ::: "memory");
}
__device__ __forceinline__ void phase0(const Args& a, unsigned char* lds, int gw, int NGW, int wave, int lane) {
    const float* w_in = a.in[4]; const float* b_in = a.in[5]; const float* w_a = a.in[9]; const float* w_b = a.in[10]; const float* w_out = a.in[11];
    bf16_t* W1T = (bf16_t*)(a.ws + WS_W1T); bf16_t* WAT = (bf16_t*)(a.ws + WS_WAT); bf16_t* WBT = (bf16_t*)(a.ws + WS_WBT); bf16_t* WOT = (bf16_t*)(a.ws + WS_WOT);
    float* scr = (float*)(lds + wave * 16384);
    constexpr int I_A = 144 * 16, I_MG = 64 * 16, I_G = 16, I_WA = 32 * 8, I_WB = 32 * 8, I_WO = 32 * 16, NITEMS = I_A + I_MG + I_G + I_WA + I_WB + I_WO;
    for (int it = gw; it < NITEMS; it += NGW) {
        int r = it;
        if (r < I_A) { p0_transpose_item(w_in, NIN, 1024, W1T, (r % 144) * 32, (r % 144) * 32, 32, (r / 144) * 64, scr, lane); continue; } r -= I_A;
        if (r < I_MG) { p0_transpose_item(w_in, NIN, 1024, W1T, 4624 + (r % 64) * 32, 4608 + (r % 64) * 32, 32, (r / 64) * 64, scr, lane); continue; } r -= I_MG;
        if (r < I_G) { p0_transpose_item(w_in, NIN, 1024, W1T, 4608, 6656, 16, r * 64, scr, lane); continue; } r -= I_G;
        if (r < I_WA) { p0_transpose_item(w_a, 1024, 512, WAT, (r % 32) * 32, (r % 32) * 32, 32, (r / 32) * 64, scr, lane); continue; } r -= I_WA;
        if (r < I_WB) { p0_transpose_item(w_b, 1024, 512, WBT, (r % 32) * 32, (r % 32) * 32, 32, (r / 32) * 64, scr, lane); continue; } r -= I_WB;
        p0_transpose_item(w_out, 1024, 1024, WOT, (r % 32) * 32, (r % 32) * 32, 32, (r / 32) * 64, scr, lane);
    }
    for (int i = gw * 64 + lane; i < (N1 - 6688) * 1024 / 8; i += NGW * 64) ((u32x4*)(W1T + (size_t)6688 * 1024))[i] = (u32x4){0u, 0u, 0u, 0u};
    float* bias1 = (float*)(a.ws + WS_BIAS1);
    for (int c = gw * 64 + lane; c < N1; c += NGW * 64) bias1[c] = c < 4608 ? b_in[c] : (c < 6656 ? b_in[4624 + (c - 4608)] : (c < 6672 ? b_in[4608 + (c - 6656)] : 0.f));
    const float* xp = a.in[0]; const float* xs = a.in[1]; const float* meta = a.in[2]; const float* g_pre = a.in[3];
    bf16_t* XN = (bf16_t*)((unsigned char*)a.out + DO_XN);
    f32x4 gv[4];
#pragma unroll
    for (int j = 0; j < 4; ++j) gv[j] = ((const f32x4*)g_pre)[lane + 64 * j];
    for (int m = gw; m < MPAD; m += NGW) {
        int b, p; row_info(m, b, p);
        unsigned long long* o8 = (unsigned long long*)(XN + (size_t)m * DM) + lane;
        if (b < 0 || p < 48) {
#pragma unroll
            for (int j = 0; j < 4; ++j) o8[64 * j] = 0ull;
            continue; }
        const float* src = p < 64 ? meta + (size_t)(p - 48) * DM : (b < NPROMPT ? xp + ((size_t)b * TP + (p - 64)) * DM : xs + ((size_t)(b - NPROMPT) * TS + (p - 64)) * DM);
        f32x4 v[4]; float s = 0.f;
#pragma unroll
        for (int j = 0; j < 4; ++j) { v[j] = __builtin_nontemporal_load((const f32x4*)src + lane + 64 * j); s += (v[j].x * v[j].x + v[j].y * v[j].y) + (v[j].z * v[j].z + v[j].w * v[j].w); }
        const float rstd = rsqrtf(wave_sum(s) * (1.f / DM) + EPS);
#pragma unroll
        for (int j = 0; j < 4; ++j) { const f32x4 y = v[j] * rstd * gv[j]; o8[64 * j] = (unsigned long long)pk2(y.x, y.y) | ((unsigned long long)pk2(y.z, y.w) << 32); }
    }
}

__device__ __forceinline__ void unpack8(const u32x4 r, float (&x)[8]) {
    x[0] = bf2f(r.x & 0xffffu); x[1] = bf2f(r.x >> 16); x[2] = bf2f(r.y & 0xffffu); x[3] = bf2f(r.y >> 16);
    x[4] = bf2f(r.z & 0xffffu); x[5] = bf2f(r.z >> 16); x[6] = bf2f(r.w & 0xffffu); x[7] = bf2f(r.w >> 16);
}

__device__ __forceinline__ void conv_phase(const Args& a, int gw, int NGW, int lane) {
    bf16_t* PROJ = (bf16_t*)(a.ws + WS_PROJ); const bf16_t* HALO = (const bf16_t*)(a.ws + WS_HALO); const float* cw = a.in[7];
    for (int it = gw; it < (MROWS / 64) * 2; it += NGW) {
        const int ci = it >> 1, half = it & 1, ch = half * 512 + 8 * lane;
        int b, p0; row_info(ci * 64, b, p0); const int Lp = seq_lp(b);
        float w0[8], w1[8], w2[8];
#pragma unroll
        for (int e = 0; e < 8; ++e) { w0[e] = cw[ch + e]; w1[e] = cw[1024 + ch + e]; w2[e] = cw[2048 + ch + e]; }
        const float sc = half ? 0.08838834764831845f : 1.0f;
        const u32x4 z4 = (u32x4){0u, 0u, 0u, 0u};
        u32x4 prev = (p0 == 0) ? z4 : *(const u32x4*)(HALO + ((size_t)(ci - 1) * 2 + 1) * 1024 + ch);
        bf16_t* colp = PROJ + (size_t)ci * 64 * LDP + C_MLQ + ch;
        for (int bt = 0; bt < 4; ++bt) {
            u32x4 cur[16];
#pragma unroll
            for (int e = 0; e < 16; ++e) { cur[e] = *(const u32x4*)(colp + (size_t)(16 * bt + e) * LDP); if (p0 + 16 * bt + e < 48) cur[e] = z4; }
            u32x4 nxt;
            if (bt < 3) { nxt = *(const u32x4*)(colp + (size_t)(16 * bt + 16) * LDP); if (p0 + 16 * bt + 16 < 48) nxt = z4; }
            else nxt = (p0 + 64 >= Lp) ? z4 : *(const u32x4*)(HALO + ((size_t)(ci + 1) * 2) * 1024 + ch);
#pragma unroll
            for (int e = 0; e < 16; ++e) { float xm[8], x0[8], xp[8], y[8];
                unpack8(e == 0 ? prev : cur[e - 1], xm); unpack8(cur[e], x0); unpack8(e == 15 ? nxt : cur[e + 1], xp);
                const bool pad = p0 + 16 * bt + e < 48;
#pragma unroll
                for (int c = 0; c < 8; ++c) { const float x = w0[c] * xm[c] + w1[c] * x0[c] + w2[c] * xp[c]; y[c] = pad ? 0.f : siluf_(x) * sc; }
                *(u32x4*)(colp + (size_t)(16 * bt + e) * LDP) = (u32x4){pk2(y[0], y[1]), pk2(y[2], y[3]), pk2(y[4], y[5]), pk2(y[6], y[7])}; }
            prev = cur[15];
        }
    }
}
__device__ __forceinline__ void phase_out(const Args& a, int gw, int NGW, int lane) {
    const bf16_t* PROJ = (const bf16_t*)(a.ws + WS_PROJ); const float* SS = (const float*)(a.ws + WS_SS); const float* g_post = a.in[12];
    const float* xp = a.in[0]; const float* xs = a.in[1];
    f32x4 gv[4];
#pragma unroll
    for (int j = 0; j < 4; ++j) gv[j] = ((const f32x4*)g_post)[lane + 64 * j];
    for (int m = gw; m < NTOK; m += NGW) {
        const size_t off = (size_t)m * DM;
        const float* src = m < NPROMPT * TP ? xp + off : xs + (off - (size_t)NPROMPT * TP * DM);
        float s = (lane < 16) ? SS[(size_t)m * 16 + lane] : 0.f; s = wave_sum(s);
        const float rstd = rsqrtf(s * (1.f / DM) + EPS);
        const u32x2* yr = (const u32x2*)(PROJ + (size_t)m * LDP + C_Y);
#pragma unroll
        for (int j = 0; j < 4; ++j) { const f32x4 xv = __builtin_nontemporal_load((const f32x4*)src + lane + 64 * j); const u32x2 yv = yr[lane + 64 * j];
            f32x4 o; o.x = xv.x + bf2f(yv.x & 0xffffu) * rstd * gv[j].x; o.y = xv.y + bf2f(yv.x >> 16) * rstd * gv[j].y; o.z = xv.z + bf2f(yv.y & 0xffffu) * rstd * gv[j].z; o.w = xv.w + bf2f(yv.y >> 16) * rstd * gv[j].w;
            __builtin_nontemporal_store(o, (f32x4*)(a.out + off) + lane + 64 * j); }
    }
}

#define XB_TMO      128
#define XB_XCNT(j)  (256  + 64 * (j))
#define XB_XSUB(j)  (1280 + 64 * (j))
#define XB_XGEN(j)  (2304 + 64 * (j))
#define XB_TOP      3328
#define XB_TOPGEN   3392
#define XCD_BAR_WORDS 3456
#define XB_SPIN_CAP (1u << 18)

__device__ __forceinline__ unsigned xb_ld(unsigned* p)              { return __hip_atomic_load(p, __ATOMIC_RELAXED, __HIP_MEMORY_SCOPE_AGENT); }
__device__ __forceinline__ unsigned xb_add(unsigned* p, unsigned v) { return __hip_atomic_fetch_add(p, v, __ATOMIC_RELAXED, __HIP_MEMORY_SCOPE_AGENT); }
__device__ __forceinline__ unsigned xb_xcc_id() { return (unsigned)__builtin_amdgcn_s_getreg((3 << 11) | 20) & 0xFu; }
#define XB_SPIN(cond, bar) do { unsigned _sp = 0; while (cond) { __builtin_amdgcn_s_sleep(1); \
    if ((++_sp & 255u) == 0u) { if (xb_ld(&(bar)[XB_TMO])) break; if (_sp > XB_SPIN_CAP) { atomicAdd(&(bar)[XB_TMO], 1u); break; } } } } while (0)

struct XcdBarrier {
    unsigned* bar; unsigned x;
    volatile LAS unsigned* st;
};

__device__ __forceinline__ XcdBarrier xcd_barrier_post(unsigned* bar, volatile LAS unsigned* st) {
    XcdBarrier b; b.bar = bar; b.x = xb_xcc_id(); b.st = st;
    if (threadIdx.x == 0) (void)xb_add(&bar[XB_XCNT(b.x)], 1u);
    return b;
}
__device__ __forceinline__ void xcd_barrier_complete(unsigned* bar, unsigned x, unsigned& nloc, unsigned& nx) {
    const unsigned G = gridDim.x * gridDim.y * gridDim.z;
    unsigned sum, cnt, mine, sp = 0u;
    for (;;) {
        sum = 0u; cnt = 0u; mine = 0u;
#pragma unroll
        for (unsigned j = 0; j < 16; ++j) { const unsigned c = xb_ld(&bar[XB_XCNT(j)]); sum += c; cnt += (c > 0u) ? 1u : 0u; mine = (j == x) ? c : mine; }
        if (sum == G) break;
        __builtin_amdgcn_s_sleep(1);
        if ((++sp & 255u) == 0u) { if (xb_ld(&bar[XB_TMO])) break; if (sp > XB_SPIN_CAP) { atomicAdd(&bar[XB_TMO], 1u); break; } }
    }
    nloc = mine > 0u ? mine : 1u; nx = cnt > 0u ? cnt : 1u;
}

__device__ __forceinline__ void xcd_barrier(const XcdBarrier& b) {
    asm volatile("s_waitcnt vmcnt(0)" ::: "memory");
    __syncthreads();
    if (threadIdx.x == 0) {
        unsigned* bar = b.bar;
        __builtin_amdgcn_s_waitcnt(0);
        unsigned nloc = b.st[0], nx = b.st[1];
        if (nloc == 0u) { xcd_barrier_complete(bar, b.x, nloc, nx); b.st[0] = nloc; b.st[1] = nx; }
        const unsigned old = xb_add(&bar[XB_XSUB(b.x)], 1u);
        const unsigned gen = old / nloc;
        if (old + 1u == (gen + 1u) * nloc) {
            __builtin_amdgcn_fence(__ATOMIC_RELEASE, "agent");
            asm volatile("s_waitcnt vmcnt(0)" ::: "memory");
            const unsigned og = xb_add(&bar[XB_TOP], 1u);
            const unsigned tg = og / nx;
            if (og + 1u == (tg + 1u) * nx) xb_add(&bar[XB_TOPGEN], 1u);
            else XB_SPIN(xb_ld(&bar[XB_TOPGEN]) == tg, bar);
            __builtin_amdgcn_fence(__ATOMIC_ACQUIRE, "agent");
            xb_add(&bar[XB_XGEN(b.x)], 1u);
            asm volatile("s_waitcnt vmcnt(0)" ::: "memory");
        } else {
            XB_SPIN(xb_ld(&bar[XB_XGEN(b.x)]) == gen, bar);
            __builtin_amdgcn_fence(__ATOMIC_ACQUIRE, "agent");
            asm volatile("s_waitcnt vmcnt(0)" ::: "memory");
        }
    }
    __syncthreads();
}

typedef short bf16x8 __attribute__((ext_vector_type(8)));
typedef float f32x16 __attribute__((ext_vector_type(16)));
constexpr int ML_PQ = 136, ML_PT = 72, ML_PC = 136;
constexpr int ML_QS = 0, ML_KS = ML_QS + 64 * ML_PQ * 2, ML_VT = ML_KS + 64 * ML_PQ * 2, ML_KT = ML_VT + 128 * ML_PT * 2, ML_CB = ML_KT + 128 * ML_PT * 2;
constexpr int ML_F32 = ML_CB + 128 * ML_PC * 2, ML_GPRE = ML_F32 + 2304 + 3072, ML_HT = ML_GPRE + 17 * 200 * 4, ML_HR = ML_HT + 64 * ML_PQ * 2, ML_VTMP = ML_HR + 1024, ML_END = ML_VTMP + 64 * ML_PQ * 2;
static_assert(ML_END <= LDS_BARST - 32, "mLSTM LDS map");
constexpr int ML_NSEGU = 16 * 8 + 64 * 4;
__device__ __forceinline__ void ml_stream_decode(int sid, int& b, int& hd, int& dir, int& nseg, int& slot0) {
    if (sid < 16) { b = 8 + (sid >> 3); hd = (sid >> 1) & 3; dir = sid & 1; nseg = 8; slot0 = sid * 8; }
    else { const int s2 = sid - 16; b = s2 >> 3; hd = (s2 >> 1) & 3; dir = s2 & 1; nseg = 4; slot0 = 128 + s2 * 4; }
}
__device__ __forceinline__ void mlstm_segment(const Args& a, unsigned char* lds, int tid, int unit) {
    const bf16_t* PROJ = (const bf16_t*)(a.ws + WS_PROJ); const float* GATES = (const float*)(a.ws + WS_GATES);
    const int lane = tid & 63, w = __builtin_amdgcn_readfirstlane(tid >> 6), l31 = lane & 31, hh = lane >> 5;
    bf16_t* Qs = (bf16_t*)(lds + ML_QS); bf16_t* Ks = (bf16_t*)(lds + ML_KS); bf16_t* VT = (bf16_t*)(lds + ML_VT); bf16_t* KT = (bf16_t*)(lds + ML_KT); bf16_t* Cb = (bf16_t*)(lds + ML_CB);
    float* Fu = (float*)(lds + ML_F32); float* Fc = Fu + 64; float* Fei = Fu + 128; float* Fwp = Fu + 256; float* Fnq = Fu + 320; float* Fn = Fu + 384; float* Fsc = Fu + 512; float* Fmt = Fu + 516; float* FL = Fu + 580;
    float* GPRE = (float*)(lds + ML_GPRE); bf16_t* HT = (bf16_t*)(lds + ML_HT); bf16_t* VTMP = (bf16_t*)(lds + ML_VTMP); f32x4* HR = (f32x4*)(lds + ML_HR);
    const int tv = w & 3, tj = w >> 2;
    {   int b, hd, dir, nseg, slot0, sid, kseg;
        if (unit < 128) { sid = unit >> 3; kseg = unit & 7; } else { sid = 16 + ((unit - 128) >> 2); kseg = (unit - 128) & 3; }
        ml_stream_decode(sid, b, hd, dir, nseg, slot0);
        const int slot = slot0 + kseg;
        const int base = seq_base(b), Lp = seq_lp(b), nc = Lp >> 6;
        const int n_begin = kseg == 0 ? 0 : 17 + 16 * (kseg - 1), n_end = 17 + 16 * kseg;
        float* ROWS = (float*)(a.ws + WS_MLROWS);
        bf16_t* H = (bf16_t*)((unsigned char*)a.out + (dir ? DO_HB : DO_HF));
        for (int i = tid; i < 128 * ML_PC * 2 / 16; i += NTHREADS) ((u32x4*)Cb)[i] = (u32x4){0u, 0u, 0u, 0u};
        if (tid < 128) Fn[tid] = 0.f;
        f32x16 X[2];
#pragma unroll
        for (int x = 0; x < 2; ++x)
#pragma unroll
            for (int i = 0; i < 16; ++i) X[x][i] = 0.f;
        float mstate = 0.f, gacc = 0.f;
        u32x4 pq[2], pk[2], pv[2];
#define ML_LOAD(n_) do { const int oc_ = dir ? nc - 1 - (n_) : (n_); \
            _Pragma("unroll") for (int i_ = 0; i_ < 2; ++i_) { const int ix_ = tid + 512 * i_, j_ = ix_ >> 4; const bf16_t* rq_ = PROJ + (size_t)(base + oc_ * 64 + (dir ? 63 - j_ : j_)) * LDP + hd * 128 + 8 * (ix_ & 15);     \
                pq[i_] = *(const u32x4*)(rq_ + C_MLQ); pk[i_] = *(const u32x4*)(rq_ + C_MLK); \
                pv[i_] = *(const u32x4*)(rq_ + C_MLV); } } while (0)
#define ML_FLUSH(n_) do { const int oc_ = dir ? nc - 1 - (n_) : (n_); \
            _Pragma("unroll") for (int i_ = 0; i_ < 2; ++i_) { const int ix_ = tid + 512 * i_, j_ = ix_ >> 4; \
                __builtin_nontemporal_store(*(const u32x4*)(HT + j_ * ML_PQ + 8 * (ix_ & 15)), (u32x4*)(H + (size_t)(base + oc_ * 64 + (dir ? 63 - j_ : j_)) * 512 + hd * 128 + 8 * (ix_ & 15))); } \
            if (w == 0) *(f32x4*)(ROWS + ((size_t)(base + oc_ * 64 + (dir ? 63 - lane : lane)) * 8 + hd * 2 + dir) * 4) = HR[lane]; } while (0)
        ML_LOAD(n_begin);
        for (int cn = n_begin + w; cn < n_end; cn += NWAVES) {
            const int oc_ = dir ? nc - 1 - cn : cn; const int p_ = oc_ * 64 + (dir ? 63 - lane : lane); const bool pad_ = p_ < 48;
            const float* gp_ = GATES + (size_t)(base + p_) * 16 + dir * 8 + hd; const float gi_ = gp_[0], gf_ = gp_[4];
            const float ig = pad_ ? -1e30f : gi_; const float lf = pad_ ? 0.f : (fminf(gf_, 0.f) - log1pf(__expf(-fabsf(gf_))));
            float bs = lf;
#pragma unroll
            for (int o = 1; o < 64; o <<= 1) { const float t = __shfl_up(bs, o); if (lane >= o) bs += t; }
            const float g = __shfl(bs, 63); const float u = ig - bs; float pm = u;
#pragma unroll
            for (int o = 1; o < 64; o <<= 1) { const float t = __shfl_up(pm, o); if (lane >= o) pm = fmaxf(pm, t); }
            const float mloc = wave_max(g + u);
            float* GP = GPRE + (cn - n_begin) * 200;
            GP[lane] = u; GP[64 + lane] = pm; GP[128 + lane] = bs; { const float umax = __shfl(pm, 63); if (lane == 0) { GP[192] = g; GP[193] = mloc; GP[194] = umax; } }
        }
        __syncthreads();
        for (int n = n_begin; n < n_end; ++n) {
            const int oc = dir ? nc - 1 - n : n;
            {
#pragma unroll
              for (int i = 0; i < 2; ++i) { const int cg = w + 8 * i; const u32x4 z4 = (u32x4){0u, 0u, 0u, 0u};
                  const int ix = tid + 512 * i, jq = ix >> 4; const bool padq = oc * 64 + (dir ? 63 - jq : jq) < 48;
                  *(u32x4*)(Qs + jq * ML_PQ + 8 * (ix & 15)) = padq ? z4 : pq[i];
                  *(u32x4*)(Ks + jq * ML_PQ + 8 * (ix & 15)) = padq ? z4 : pk[i];
                  *(u32x4*)(VTMP + jq * ML_PQ + 8 * (ix & 15)) = padq ? z4 : pv[i]; (void)cg; }
              if (w == 7) {
                  const float* GP = GPRE + (n - n_begin) * 200;
                  const float u = GP[lane], pm = GP[64 + lane], bs = GP[128 + lane], g = GP[192], mloc = GP[193], umax = GP[194];
                  const float c = fmaxf(pm, mstate);
                  Fu[lane] = __expf(u - umax); Fc[lane] = __expf(umax - c); Fei[lane] = __expf(mstate - c); Fmt[lane] = bs + c; FL[lane] = gacc + bs;
                  const float mnew = fmaxf(g + mstate, mloc);
                  Fwp[lane] = __expf(g + u - mnew); if (lane == 0) Fsc[0] = __expf(g + mstate - mnew); mstate = mnew; gacc += g;
              }
            }
            if (n + 1 < n_end) ML_LOAD(n + 1);
            LDS_BARRIER();
            if (n > n_begin) ML_FLUSH(n - 1);
            { const int s = lane; const float wp = Fwp[s], eu = Fu[s];
#pragma unroll
              for (int i = 0; i < 2; ++i) { const int cg = w + 8 * i; float kk[8]; unpack8(*(const u32x4*)(Ks + s * ML_PQ + 8 * cg), kk);
                  { const u32x4 vv = *(const u32x4*)(VTMP + s * ML_PQ + 8 * cg); bf16_t* vt = VT + (8 * cg) * ML_PT + s;
                    vt[0 * ML_PT] = (bf16_t)(vv.x & 0xffffu); vt[1 * ML_PT] = (bf16_t)(vv.x >> 16); vt[2 * ML_PT] = (bf16_t)(vv.y & 0xffffu); vt[3 * ML_PT] = (bf16_t)(vv.y >> 16);
                    vt[4 * ML_PT] = (bf16_t)(vv.z & 0xffffu); vt[5 * ML_PT] = (bf16_t)(vv.z >> 16); vt[6 * ML_PT] = (bf16_t)(vv.w & 0xffffu); vt[7 * ML_PT] = (bf16_t)(vv.w >> 16); }
#pragma unroll
                  for (int e = 0; e < 8; e += 2) { const unsigned pr = pk2(kk[e] * wp, kk[e + 1] * wp); KT[(8 * cg + e) * ML_PT + s] = (bf16_t)(pr & 0xffffu); KT[(8 * cg + e + 1) * ML_PT + s] = (bf16_t)(pr >> 16); }
                  *(u32x4*)(Ks + s * ML_PQ + 8 * cg) = (u32x4){pk2(kk[0] * eu, kk[1] * eu), pk2(kk[2] * eu, kk[3] * eu), pk2(kk[4] * eu, kk[5] * eu), pk2(kk[6] * eu, kk[7] * eu)}; }
              const int j = tid >> 3, part = tid & 7; float qv[8], d = 0.f;
#pragma unroll
              for (int q2 = 0; q2 < 2; ++q2) { unpack8(*(const u32x4*)(Qs + j * ML_PQ + 16 * part + 8 * q2), qv);
#pragma unroll
                  for (int e = 0; e < 8; ++e) d += qv[e] * Fn[16 * part + 8 * q2 + e]; }
              d += __shfl_xor(d, 1); d += __shfl_xor(d, 2); d += __shfl_xor(d, 4);
              if (part == 0) Fnq[j] = d; }
            LDS_BARRIER();
            { f32x16 acc1, acc2;
#pragma unroll
              for (int i = 0; i < 16; ++i) { acc1[i] = 0.f; acc2[i] = 0.f; }
              float den1 = 0.f; const int jcol = 32 * tj + l31; const float cj = Fc[jcol];
              for (int ts = 0; ts <= tj; ++ts) {
                  f32x16 S;
#pragma unroll
                  for (int i = 0; i < 16; ++i) S[i] = 0.f;
#pragma unroll
                  for (int t = 0; t < 8; ++t) { const bf16x8 A = *(const bf16x8*)(Ks + (32 * ts + l31) * ML_PQ + 16 * t + 8 * hh); const bf16x8 B = *(const bf16x8*)(Qs + jcol * ML_PQ + 16 * t + 8 * hh);
                      S = __builtin_amdgcn_mfma_f32_32x32x16_bf16(A, B, S, 0, 0, 0); }
#pragma unroll
                  for (int i = 0; i < 16; ++i) { const int s = 32 * ts + 8 * (i >> 2) + 4 * hh + (i & 3); if (ts == tj) S[i] = (s <= jcol) ? S[i] : 0.f; den1 += S[i]; }
#pragma unroll
                  for (int t2 = 0; t2 < 2; ++t2) {
                      const u32x4 bw = (u32x4){pk2(S[8 * t2 + 0], S[8 * t2 + 1]), pk2(S[8 * t2 + 2], S[8 * t2 + 3]), pk2(S[8 * t2 + 4], S[8 * t2 + 5]), pk2(S[8 * t2 + 6], S[8 * t2 + 7])};
                      const bf16_t* vp = VT + (32 * tv + l31) * ML_PT + 32 * ts + 16 * t2 + 4 * hh; const u32x2 lo = *(const u32x2*)vp, hi = *(const u32x2*)(vp + 8);
                      const u32x4 aw = (u32x4){lo.x, lo.y, hi.x, hi.y};
                      acc1 = __builtin_amdgcn_mfma_f32_32x32x16_bf16(__builtin_bit_cast(bf16x8, aw), __builtin_bit_cast(bf16x8, bw), acc1, 0, 0, 0); }
              }
              den1 += __shfl_xor(den1, 32);
#pragma unroll
              for (int t = 0; t < 8; ++t) { const bf16x8 A = *(const bf16x8*)(Cb + (32 * tv + l31) * ML_PC + 16 * t + 8 * hh); const bf16x8 B = *(const bf16x8*)(Qs + jcol * ML_PQ + 16 * t + 8 * hh);
                  acc2 = __builtin_amdgcn_mfma_f32_32x32x16_bf16(A, B, acc2, 0, 0, 0); }
              const float ei = Fei[jcol]; const float den = den1 * cj + ei * Fnq[jcol];
              { bf16_t* hp = HT + jcol * ML_PQ + 32 * tv + 4 * hh;
#pragma unroll
                  for (int g4 = 0; g4 < 4; ++g4) { u32x2 o; o.x = pk2(acc1[4 * g4] * cj + ei * acc2[4 * g4], acc1[4 * g4 + 1] * cj + ei * acc2[4 * g4 + 1]);
                      o.y = pk2(acc1[4 * g4 + 2] * cj + ei * acc2[4 * g4 + 2], acc1[4 * g4 + 3] * cj + ei * acc2[4 * g4 + 3]); *(u32x2*)(hp + 8 * g4) = o; }
                  if (tv == 0 && hh == 0) HR[jcol] = (f32x4){Fmt[jcol], FL[jcol], den, 0.f}; }
              const float fs = Fsc[0];
#pragma unroll
              for (int x = 0; x < 2; ++x) { const int tk = 2 * tj + x;
#pragma unroll
                  for (int i = 0; i < 16; ++i) X[x][i] *= fs;
#pragma unroll
                  for (int t = 0; t < 4; ++t) { const bf16x8 A = *(const bf16x8*)(KT + (32 * tk + l31) * ML_PT + 16 * t + 8 * hh); const bf16x8 B = *(const bf16x8*)(VT + (32 * tv + l31) * ML_PT + 16 * t + 8 * hh);
                      X[x] = __builtin_amdgcn_mfma_f32_32x32x16_bf16(A, B, X[x], 0, 0, 0); } }
              { const int k = tid >> 2, part = tid & 3; float kv[8], sm = 0.f;
#pragma unroll
                for (int q2 = 0; q2 < 2; ++q2) { unpack8(*(const u32x4*)(KT + k * ML_PT + 16 * part + 8 * q2), kv);
#pragma unroll
                    for (int e = 0; e < 8; ++e) sm += kv[e]; }
                sm += __shfl_xor(sm, 1); sm += __shfl_xor(sm, 2);
                if (part == 0) Fn[k] = fs * Fn[k] + sm; }
            }
            LDS_BARRIER();
#pragma unroll
            for (int x = 0; x < 2; ++x) { const int tk = 2 * tj + x; bf16_t* cp = Cb + (32 * tv + l31) * ML_PC + 32 * tk + 4 * hh;
#pragma unroll
                for (int g4 = 0; g4 < 4; ++g4) { u32x2 o; o.x = pk2(X[x][4 * g4], X[x][4 * g4 + 1]); o.y = pk2(X[x][4 * g4 + 2], X[x][4 * g4 + 3]); *(u32x2*)(cp + 8 * g4) = o; } }
        }
        __syncthreads();
        ML_FLUSH(n_end - 1);
        { unsigned long long* SX = (unsigned long long*)((bf16_t*)(a.ws + WS_SEGX) + (size_t)slot * 16384);
          for (int i = tid; i < 2048; i += NTHREADS) { const int v = i >> 4, c8 = i & 15; const u32x4 xv = *(const u32x4*)(Cb + v * ML_PC + 8 * c8);
              __hip_atomic_store(SX + (v * 128 + 8 * c8) / 4, ((unsigned long long)xv.y << 32) | xv.x, __ATOMIC_RELAXED, __HIP_MEMORY_SCOPE_AGENT);
              __hip_atomic_store(SX + (v * 128 + 8 * c8) / 4 + 1, ((unsigned long long)xv.w << 32) | xv.z, __ATOMIC_RELAXED, __HIP_MEMORY_SCOPE_AGENT); }
          float* SN = (float*)(a.ws + WS_SEGN) + (size_t)slot * 132;
          if (tid < 128) __hip_atomic_store(SN + tid, Fn[tid], __ATOMIC_RELAXED, __HIP_MEMORY_SCOPE_AGENT);
          if (w == 7 && lane == 0) { __hip_atomic_store(SN + 128, mstate, __ATOMIC_RELAXED, __HIP_MEMORY_SCOPE_AGENT); __hip_atomic_store(SN + 129, gacc, __ATOMIC_RELAXED, __HIP_MEMORY_SCOPE_AGENT); } }
        asm volatile("s_waitcnt vmcnt(0)" ::: "memory");
        __syncthreads();
#undef ML_LOAD
#undef ML_FLUSH
    }
}
__device__ __forceinline__ void mlstm_chain(const Args& a, int tid, int sid) {
    {
        int b, hd, dir, nseg, slot0; ml_stream_decode(sid, b, hd, dir, nseg, slot0);
        float C[32]; float nn = 0.f, M = 0.f;
#pragma unroll
        for (int i = 0; i < 32; ++i) C[i] = 0.f;
        for (int k = 0; k < nseg; ++k) {
            bf16_t* ST = (bf16_t*)(a.ws + WS_START) + (size_t)(slot0 + k) * 16384; float* STN = (float*)(a.ws + WS_STARTN) + (size_t)(slot0 + k) * 132;
#pragma unroll
            for (int q = 0; q < 4; ++q) *(u32x4*)(ST + tid * 32 + 8 * q) = (u32x4){pk2(C[8 * q], C[8 * q + 1]), pk2(C[8 * q + 2], C[8 * q + 3]), pk2(C[8 * q + 4], C[8 * q + 5]), pk2(C[8 * q + 6], C[8 * q + 7])};
            if (tid < 128) STN[tid] = nn;
            if (tid == 0) STN[128] = M;
            if (k + 1 == nseg) break;
            const bf16_t* SX = (const bf16_t*)(a.ws + WS_SEGX) + (size_t)(slot0 + k) * 16384; const float* SN = (const float*)(a.ws + WS_SEGN) + (size_t)(slot0 + k) * 132;
            const float mend = SN[128], gt = SN[129]; const float M2 = fmaxf(gt + M, mend); const float ca = __expf(gt + M - M2), cb = __expf(mend - M2); M = M2;
#pragma unroll
            for (int q = 0; q < 4; ++q) { float xv[8]; unpack8(*(const u32x4*)(SX + tid * 32 + 8 * q), xv);
#pragma unroll
                for (int e = 0; e < 8; ++e) C[8 * q + e] = ca * C[8 * q + e] + cb * xv[e]; }
            if (tid < 128) nn = ca * nn + cb * SN[tid];
        }
    }
}
__device__ __forceinline__ int ml_slot_of(int row0, int hd, int dir) {
    int b, p0; row_info(row0, b, p0); const int nc = seq_lp(b) >> 6, oc = p0 >> 6; const int n = dir ? nc - 1 - oc : oc; const int k = n < 17 ? 0 : 1 + ((n - 17) >> 4);
    return (b >= NPROMPT ? ((b - 8) * 8 + hd * 2 + dir) * 8 : 128 + (b * 8 + hd * 2 + dir) * 4) + k;
}
constexpr int MF_QCTL = 4 * 128 * 136 * 2 + 64;
constexpr int MF_PITCH = 136;
__device__ __forceinline__ void mlstm_finish(const Args& a, unsigned char* lds, int tid) {
    bf16_t* PROJ = (bf16_t*)(a.ws + WS_PROJ); const float* head_g = a.in[8]; const float* ROWS = (const float*)(a.ws + WS_MLROWS);
    const int lane = tid & 63, w = __builtin_amdgcn_readfirstlane(tid >> 6), jl = lane & 15, g = lane >> 4;
    const int NCH = MROWS / 64;
    volatile int* QC = (volatile int*)(lds + MF_QCTL);
    for (;;) {
        __syncthreads();
        if (tid == 0) QC[0] = (int)atomicAdd((unsigned*)a.ws + 1, 1u);
        __syncthreads();
        const int it = QC[0];
        if (it >= (NCH / 2) * 4) break;
        const int hd = it & 3, ci = (it >> 2) * 2 + (w >> 2);
        int b, p0; row_info(ci * 64, b, p0);
        const int nc = seq_lp(b) >> 6, oc = p0 >> 6;
        int sl[2][2];
#pragma unroll
        for (int st = 0; st < 4; ++st) { const int c2 = st >> 1, sdir = st & 1; sl[c2][sdir] = ml_slot_of(((it >> 2) * 2 + c2) * 64, hd, sdir); }
#pragma unroll
        for (int st = 0; st < 4; ++st) {
            const int c2 = st >> 1, sdir = st & 1;
            if (c2 == 1 && sl[1][sdir] == sl[0][sdir]) continue;
            const bf16_t* src = (const bf16_t*)(a.ws + WS_START) + (size_t)sl[c2][sdir] * 16384; bf16_t* dst = (bf16_t*)lds + st * 128 * MF_PITCH;
#pragma unroll
            for (int q = 0; q < 4; ++q) { const int pc = tid + 512 * q, v = pc >> 4, c8 = pc & 15; *(u32x4*)(dst + v * MF_PITCH + 8 * c8) = *(const u32x4*)(src + v * 128 + 8 * c8); } }
        __syncthreads();
        const int row = ci * 64 + 16 * (w & 3) + jl; const int p = p0 + 16 * (w & 3) + jl;
        const bf16_t* qp = PROJ + (size_t)row * LDP + C_MLQ + hd * 128 + 8 * g;
        bf16x8 qf[4];
#pragma unroll
        for (int t = 0; t < 4; ++t) qf[t] = *(const bf16x8*)(qp + 32 * t);
        float hsum[32];
#pragma unroll
        for (int i = 0; i < 32; ++i) hsum[i] = 0.f;
#pragma unroll
        for (int dir = 0; dir < 2; ++dir) {
            const int n = dir ? nc - 1 - oc : oc; const int kseg = n < 17 ? 0 : 1 + ((n - 17) >> 4);
            const int sid = b >= NPROMPT ? ((b - 8) * 8 + hd * 2 + dir) : (16 + b * 8 + hd * 2 + dir);
            const int slot = (b >= NPROMPT ? sid * 8 : 128 + (sid - 16) * 4) + kseg;
            const bf16_t* ST = (const bf16_t*)lds + (((w >> 2) && sl[1][dir] != sl[0][dir] ? 2 : 0) + dir) * 128 * MF_PITCH; const float* STN = (const float*)(a.ws + WS_STARTN) + (size_t)slot * 132;
            const bf16_t* NUM = (const bf16_t*)((const unsigned char*)a.out + (dir ? DO_HB : DO_HF)) + (size_t)row * 512 + hd * 128 + 8 * g;
            const f32x4 rs = *(const f32x4*)(ROWS + ((size_t)row * 8 + hd * 2 + dir) * 4);
            const float M = STN[128]; const float mf = fmaxf(rs.x, rs.y + M); const float sA = __expf(rs.x - mf), sB = __expf(rs.y + M - mf);
            float nq = 0.f;
#pragma unroll
            for (int t = 0; t < 4; ++t) { float qv[8]; unpack8(__builtin_bit_cast(u32x4, qf[t]), qv); const f32x4 n0 = *(const f32x4*)(STN + 32 * t + 8 * g), n1 = *(const f32x4*)(STN + 32 * t + 8 * g + 4);
                nq += qv[0] * n0.x + qv[1] * n0.y + qv[2] * n0.z + qv[3] * n0.w + qv[4] * n1.x + qv[5] * n1.y + qv[6] * n1.z + qv[7] * n1.w; }
            nq += __shfl_xor(nq, 16); nq += __shfl_xor(nq, 32);
            const float den = rs.z * sA + sB * nq; const float inv = 1.0f / fmaxf(fabsf(den), __expf(-mf));
#pragma unroll
            for (int mp = 0; mp < 4; ++mp) {
                f32x4 acc0 = (f32x4){0.f, 0.f, 0.f, 0.f}, acc1 = (f32x4){0.f, 0.f, 0.f, 0.f};
                const bf16_t* sr = ST + (32 * mp + 8 * (jl >> 2) + (jl & 3)) * MF_PITCH + 8 * g;
#pragma unroll
                for (int t = 0; t < 4; ++t) { acc0 = __builtin_amdgcn_mfma_f32_16x16x32_bf16(*(const bf16x8*)(sr + 32 * t), qf[t], acc0, 0, 0, 0);
                    acc1 = __builtin_amdgcn_mfma_f32_16x16x32_bf16(*(const bf16x8*)(sr + 4 * MF_PITCH + 32 * t), qf[t], acc1, 0, 0, 0); }
                float nv[8]; unpack8(*(const u32x4*)(NUM + 32 * mp), nv);
#pragma unroll
                for (int i = 0; i < 4; ++i) { hsum[8 * mp + i] += (nv[i] * sA + sB * acc0[i]) * inv; hsum[8 * mp + 4 + i] += (nv[4 + i] * sA + sB * acc1[i]) * inv; } }
        }
        bf16_t* prow = PROJ + (size_t)row * LDP; float s1 = 0.f;
#pragma unroll
        for (int mp = 0; mp < 4; ++mp) { float ov[8]; unpack8(*(const u32x4*)(prow + C_MLO + hd * 128 + 32 * mp + 8 * g), ov);
#pragma unroll
            for (int e = 0; e < 8; ++e) { hsum[8 * mp + e] *= sigmoidf_(ov[e]); s1 += hsum[8 * mp + e]; } }
        s1 += __shfl_xor(s1, 16); s1 += __shfl_xor(s1, 32); const float mu = s1 * (1.f / 128.f); float s2 = 0.f;
#pragma unroll
        for (int i = 0; i < 32; ++i) { hsum[i] -= mu; s2 += hsum[i] * hsum[i]; }
        s2 += __shfl_xor(s2, 16); s2 += __shfl_xor(s2, 32); const float rstd = rsqrtf(s2 * (1.f / 128.f) + EPS);
        if (p >= 48) {
#pragma unroll
            for (int mp = 0; mp < 4; ++mp) { const int cc = hd * 128 + 32 * mp + 8 * g; float zv[8]; unpack8(*(const u32x4*)(prow + C_MLZ + cc), zv); const f32x4 h0 = *(const f32x4*)(head_g + cc), h1 = *(const f32x4*)(head_g + cc + 4);
                const float* hs = hsum + 8 * mp;
                *(u32x4*)(prow + C_YB + cc) = (u32x4){pk2(hs[0] * rstd * h0.x * siluf_(zv[0]), hs[1] * rstd * h0.y * siluf_(zv[1])), pk2(hs[2] * rstd * h0.z * siluf_(zv[2]), hs[3] * rstd * h0.w * siluf_(zv[3])),
                                                      pk2(hs[4] * rstd * h1.x * siluf_(zv[4]), hs[5] * rstd * h1.y * siluf_(zv[5])), pk2(hs[6] * rstd * h1.z * siluf_(zv[6]), hs[7] * rstd * h1.w * siluf_(zv[7]))}; } }
    }
}
constexpr int NA3_K = 0, NA3_KM = 73728, NA3_VT = 75776, NA3_PITCH = 600, NA3_RPB = NA3_VT + 64 * NA3_PITCH * 2, NA_CTL = NA3_RPB + 15 * 64 * 4, NA_END = NA_CTL + 16;
static_assert(NA_END <= LDS_BARST, "NA LDS map");
constexpr int NA_UNITS = 2 * 8 * 16 + 8 * 8 * 8;
__device__ __forceinline__ void na_vt_store(bf16_t* vt, const u32x4 vv) {
    vt[0 * NA3_PITCH] = (bf16_t)(vv.x & 0xffffu); vt[1 * NA3_PITCH] = (bf16_t)(vv.x >> 16); vt[2 * NA3_PITCH] = (bf16_t)(vv.y & 0xffffu); vt[3 * NA3_PITCH] = (bf16_t)(vv.y >> 16);
    vt[4 * NA3_PITCH] = (bf16_t)(vv.z & 0xffffu); vt[5 * NA3_PITCH] = (bf16_t)(vv.z >> 16); vt[6 * NA3_PITCH] = (bf16_t)(vv.w & 0xffffu); vt[7 * NA3_PITCH] = (bf16_t)(vv.w >> 16);
}
__device__ __forceinline__ void na_unit(const Args& a, unsigned char* lds, int tid, int u) {
    bf16_t* PROJ = (bf16_t*)(a.ws + WS_PROJ); const float* rpb = a.in[6];
    const int lane = tid & 63, w = __builtin_amdgcn_readfirstlane(tid >> 6), ql = lane & 15, g = lane >> 4;
    unsigned char* KR = lds + NA3_K; unsigned char* KM = lds + NA3_KM; bf16_t* VT = (bf16_t*)(lds + NA3_VT); float* RPB = (float*)(lds + NA3_RPB);
    const int cb = w & 3, rr = w >> 2;
    const int kc0 = min(max(16 * cb - 8, 0), 32);
    const int cq = 16 * cb + ql, c0q = min(max(cq - 8, 0), 48);
    float mneg[2][4];
#pragma unroll
    for (int hf = 0; hf < 2; ++hf)
#pragma unroll
        for (int i = 0; i < 4; ++i) { const int kc = kc0 + 16 * hf + 4 * g + i; mneg[hf][i] = ((kc >= c0q) && (kc < c0q + 16)) ? 0.f : -INFINITY; }
    const int dcb = kc0 + 4 * g - cq + 15 + 16;
    const int ksw0 = ((0 + g) ^ (ql & 7)) << 4, ksw1 = ((4 + g) ^ (ql & 7)) << 4;
    int b, h, seg;
    if (u < 256) { b = 8 + (u >> 7); h = (u >> 4) & 7; seg = u & 15; } else { u -= 256; b = u >> 6; h = (u >> 3) & 7; seg = u & 7; }
    const int rows = b < NPROMPT ? 64 : 128, base = seq_base(b);
    const int r_begin = seg * 8, r_end = r_begin + 8;
    const bf16_t* kvbase = PROJ + (size_t)(base + 64) * LDP + h * 64;
    for (int i = tid; i < 960; i += NTHREADS) { const int rrow = i >> 6, cc = (i & 63) - 16; RPB[i] = (cc >= 0 && cc < 31) ? rpb[(h * 15 + rrow) * 31 + cc] * 1.4426950408889634f : 0.f; }
    if (tid < 128) { const int t = tid >> 3, c = tid & 7; *(u32x4*)(KM + t * 128 + ((c ^ (t & 7)) << 4)) = *(const u32x4*)(PROJ + (size_t)(base + 48 + t) * LDP + C_NAK + h * 64 + 8 * c); }
    else if (tid < 256) { const int t = tid & 15, c = (tid >> 4) & 7; na_vt_store(VT + (8 * c) * NA3_PITCH + t, *(const u32x4*)(PROJ + (size_t)(base + 48 + t) * LDP + C_NAV + h * 64 + 8 * c)); }
    int loaded = min(max(r_begin - 4, 0), rows - 8);
    { const int need = min(max(r_begin + 1 - 4, 0), rows - 8) + 8;
      for (int kr = loaded; kr < need; kr += 3) {
          u32x4 tk[3], tv[3];
#pragma unroll
          for (int q = 0; q < 3; ++q) if (kr + q < need) { tk[q] = *(const u32x4*)(kvbase + (size_t)((kr + q) * 64 + (tid >> 3)) * LDP + C_NAK + 8 * (tid & 7)); tv[q] = *(const u32x4*)(kvbase + (size_t)((kr + q) * 64 + lane) * LDP + C_NAV + 8 * w); }
#pragma unroll
          for (int q = 0; q < 3; ++q) if (kr + q < need) { const int slot = (kr + q) % 9; *(u32x4*)(KR + slot * 8192 + (tid >> 3) * 128 + (((tid & 7) ^ ((tid >> 3) & 7)) << 4)) = tk[q]; na_vt_store(VT + (8 * w) * NA3_PITCH + 16 + slot * 64 + lane, tv[q]); } }
      loaded = need; }
    if (seg == 0) {
        __syncthreads();
        if (w == 0) {
            bf16_t* qp = PROJ + (size_t)(base + 48 + ql) * LDP; bf16x8 qf[2];
#pragma unroll
            for (int s = 0; s < 2; ++s) qf[s] = *(const bf16x8*)(qp + C_NAQ + h * 64 + 32 * s + 8 * g);
            f32x4 acc = (f32x4){0.f, 0.f, 0.f, 0.f};
            acc = __builtin_amdgcn_mfma_f32_16x16x32_bf16(*(const bf16x8*)(KM + ql * 128 + ksw0), qf[0], acc, 0, 0, 0);
            acc = __builtin_amdgcn_mfma_f32_16x16x32_bf16(*(const bf16x8*)(KM + ql * 128 + ksw1), qf[1], acc, 0, 0, 0);
            acc = acc * (0.125f * 1.4426950408889634f);
            float mx = fmaxf(fmaxf(acc[0], acc[1]), fmaxf(acc[2], acc[3])); mx = fmaxf(mx, __shfl_xor(mx, 16)); mx = fmaxf(mx, __shfl_xor(mx, 32));
            float sum = 0.f;
#pragma unroll
            for (int i = 0; i < 4; ++i) { acc[i] = __builtin_amdgcn_exp2f(acc[i] - mx); sum += acc[i]; }
            sum += __shfl_xor(sum, 16); sum += __shfl_xor(sum, 32);
            const u32x4 bw = (u32x4){pk2(acc[0], acc[1]), pk2(acc[2], acc[3]), 0u, 0u}; const float inv = 1.0f / sum;
#pragma unroll
            for (int dt = 0; dt < 4; ++dt) { const u32x2 lo = *(const u32x2*)(VT + (size_t)(16 * dt + ql) * NA3_PITCH + 4 * g); const u32x4 aw = (u32x4){lo.x, lo.y, 0u, 0u};
                const f32x4 O = __builtin_amdgcn_mfma_f32_16x16x32_bf16(__builtin_bit_cast(bf16x8, aw), __builtin_bit_cast(bf16x8, bw), (f32x4){0.f, 0.f, 0.f, 0.f}, 0, 0, 0);
                const u32x2 zv = *(const u32x2*)(qp + C_NAZ + h * 64 + 16 * dt + 4 * g);
                u32x2 o; o.x = pk2(O[0] * inv * siluf_(bf2f(zv.x & 0xffffu)), O[1] * inv * siluf_(bf2f(zv.x >> 16))); o.y = pk2(O[2] * inv * siluf_(bf2f(zv.y & 0xffffu)), O[3] * inv * siluf_(bf2f(zv.y >> 16)));
                *(u32x2*)(qp + C_YA + h * 64 + 16 * dt + 4 * g) = o; }
        }
    }
    bf16x8 qn[2]; u32x2 zn[4];
    { const bf16_t* qp = PROJ + (size_t)(base + 64 + (r_begin + rr) * 64 + 16 * cb + ql) * LDP + h * 64;
#pragma unroll
      for (int s = 0; s < 2; ++s) qn[s] = *(const bf16x8*)(qp + C_NAQ + 32 * s + 8 * g);
#pragma unroll
      for (int dt = 0; dt < 4; ++dt) zn[dt] = *(const u32x2*)(qp + C_NAZ + 16 * dt + 4 * g); }
    int npre = 0; u32x4 prk[2], prv[2];
    for (int r = r_begin; r < r_end; r += 2) {
#pragma unroll
        for (int q = 0; q < 2; ++q) if (q < npre) { const int slot = (loaded + q) % 9; *(u32x4*)(KR + slot * 8192 + (tid >> 3) * 128 + (((tid & 7) ^ ((tid >> 3) & 7)) << 4)) = prk[q]; na_vt_store(VT + (8 * w) * NA3_PITCH + 16 + slot * 64 + lane, prv[q]); }
        loaded += npre;
        LDS_BARRIER();
        npre = 0;
        if (r + 2 < r_end) { npre = min(max(r + 3 - 4, 0), rows - 8) + 8 - loaded;
#pragma unroll
            for (int q = 0; q < 2; ++q) if (q < npre) { prk[q] = *(const u32x4*)(kvbase + (size_t)((loaded + q) * 64 + (tid >> 3)) * LDP + C_NAK + 8 * (tid & 7)); prv[q] = *(const u32x4*)(kvbase + (size_t)((loaded + q) * 64 + lane) * LDP + C_NAV + 8 * w); } }
        const int rw = r + rr, r0 = min(max(rw - 4, 0), rows - 8);
        bf16_t* qp = PROJ + (size_t)(base + 64 + rw * 64 + 16 * cb + ql) * LDP + h * 64;
        bf16x8 qf[2] = {qn[0], qn[1]}; u32x2 zf[4] = {zn[0], zn[1], zn[2], zn[3]};
        if (r + 2 < r_end) { const bf16_t* qp2 = qp + (size_t)128 * LDP;
#pragma unroll
            for (int s = 0; s < 2; ++s) qn[s] = *(const bf16x8*)(qp2 + C_NAQ + 32 * s + 8 * g);
#pragma unroll
            for (int dt = 0; dt < 4; ++dt) zn[dt] = *(const u32x2*)(qp2 + C_NAZ + 16 * dt + 4 * g); }
        f32x4 S[17];
        __builtin_amdgcn_s_setprio(1);
        { f32x4 acc = (f32x4){0.f, 0.f, 0.f, 0.f};
          acc = __builtin_amdgcn_mfma_f32_16x16x32_bf16(*(const bf16x8*)(KM + ql * 128 + ksw0), qf[0], acc, 0, 0, 0);
          acc = __builtin_amdgcn_mfma_f32_16x16x32_bf16(*(const bf16x8*)(KM + ql * 128 + ksw1), qf[1], acc, 0, 0, 0);
          S[0] = acc * (0.125f * 1.4426950408889634f); }
#pragma unroll
        for (int t = 1; t < 17; ++t) { const int w8 = (t - 1) >> 1, hf = (t - 1) & 1;
            const unsigned char* kp = KR + ((r0 + w8) % 9) * 8192 + (kc0 + 16 * hf + ql) * 128;
            f32x4 acc = (f32x4){0.f, 0.f, 0.f, 0.f};
            acc = __builtin_amdgcn_mfma_f32_16x16x32_bf16(*(const bf16x8*)(kp + ksw0), qf[0], acc, 0, 0, 0);
            acc = __builtin_amdgcn_mfma_f32_16x16x32_bf16(*(const bf16x8*)(kp + ksw1), qf[1], acc, 0, 0, 0);
            const float* rp = RPB + (r0 + w8 - rw + 7) * 64 + dcb + 16 * hf;
#pragma unroll
            for (int i = 0; i < 4; ++i) acc[i] = acc[i] * (0.125f * 1.4426950408889634f) + rp[i] + mneg[hf][i];
            S[t] = acc;
            if ((t & 3) == 0) asm volatile("" ::: "memory"); }
        __builtin_amdgcn_s_setprio(0);
        float mx = -INFINITY;
#pragma unroll
        for (int t = 0; t < 17; ++t) mx = fmaxf(mx, fmaxf(fmaxf(S[t][0], S[t][1]), fmaxf(S[t][2], S[t][3])));
        mx = fmaxf(mx, __shfl_xor(mx, 16)); mx = fmaxf(mx, __shfl_xor(mx, 32));
        float sum = 0.f;
#pragma unroll
        for (int t = 0; t < 17; ++t)
#pragma unroll
            for (int i = 0; i < 4; ++i) { const float p = __builtin_amdgcn_exp2f(S[t][i] - mx); S[t][i] = p; sum += p; }
        sum += __shfl_xor(sum, 16); sum += __shfl_xor(sum, 32);
        f32x4 O[4];
#pragma unroll
        for (int dt = 0; dt < 4; ++dt) O[dt] = (f32x4){0.f, 0.f, 0.f, 0.f};
        const bf16_t* vtx = VT + (size_t)ql * NA3_PITCH + 4 * g;
#pragma unroll
        for (int ks = 0; ks < 9; ++ks) {
            const int ta = 2 * ks, tb = 2 * ks + 1;
            const u32x4 bw = (u32x4){pk2(S[ta][0], S[ta][1]), pk2(S[ta][2], S[ta][3]), tb < 17 ? pk2(S[tb < 17 ? tb : 16][0], S[tb < 17 ? tb : 16][1]) : 0u, tb < 17 ? pk2(S[tb < 17 ? tb : 16][2], S[tb < 17 ? tb : 16][3]) : 0u};
            const int offa = ta == 0 ? 0 : 16 + ((r0 + ((ta - 1) >> 1)) % 9) * 64 + kc0 + 16 * ((ta - 1) & 1);
            const int offb = tb < 17 ? 16 + ((r0 + ((tb - 1) >> 1)) % 9) * 64 + kc0 + 16 * ((tb - 1) & 1) : 0;
#pragma unroll
            for (int dt = 0; dt < 4; ++dt) { const u32x2 lo = *(const u32x2*)(vtx + 16 * dt * NA3_PITCH + offa); u32x2 hi = (u32x2){0u, 0u};
                if (tb < 17) hi = *(const u32x2*)(vtx + 16 * dt * NA3_PITCH + offb);
                const u32x4 aw = (u32x4){lo.x, lo.y, hi.x, hi.y};
                O[dt] = __builtin_amdgcn_mfma_f32_16x16x32_bf16(__builtin_bit_cast(bf16x8, aw), __builtin_bit_cast(bf16x8, bw), O[dt], 0, 0, 0); }
        }
        const float inv = 1.0f / sum;
#pragma unroll
        for (int dt = 0; dt < 4; ++dt) { const u32x2 zv = zf[dt];
            u32x2 o; o.x = pk2(O[dt][0] * inv * siluf_(bf2f(zv.x & 0xffffu)), O[dt][1] * inv * siluf_(bf2f(zv.x >> 16)));
            o.y = pk2(O[dt][2] * inv * siluf_(bf2f(zv.y & 0xffffu)), O[dt][3] * inv * siluf_(bf2f(zv.y >> 16)));
            *(u32x2*)(qp + C_YA + 16 * dt + 4 * g) = o; }
        LDS_BARRIER();
    }
}
__global__ void __launch_bounds__(NTHREADS, 2) hybrid_fwd(Args args) {
    extern __shared__ __attribute__((aligned(16))) unsigned char lds[];
    const int tid = threadIdx.x, lane = tid & 63, wave = __builtin_amdgcn_readfirstlane(tid >> 6);
    const int G = gridDim.x, gw = blockIdx.x * NWAVES + wave, NGW = G * NWAVES;
    unsigned char* ws = args.ws;
    bf16_t* PROJ = (bf16_t*)(ws + WS_PROJ);
    unsigned char* mgq_lo = (unsigned char*)args.out + DO_MGQ_LO; unsigned char* mgq_hi = ws + WS_MGQ_HI;
    volatile LAS unsigned* barst = (volatile LAS unsigned*)((LAS unsigned char*)lds + LDS_BARST);
    if (tid < 2) barst[tid] = 0u;
    __syncthreads();
    XcdBarrier bar = xcd_barrier_post((unsigned*)(ws + WS_BAR), barst);
    const int lo = args.ph_lo, hi = args.ph_hi;
#define IN(k) (lo <= (k) && (k) < hi)
#define SEAM(k) do { if (IN(k) && IN((k) + 1)) xcd_barrier(bar); } while (0)
    if (args.coop == 2) cg::this_grid().sync();
    if (IN(0)) phase0(args, lds, gw, NGW, wave, lane);
    SEAM(0);
    if (IN(1)) {   pg8::Gemm g{(const bf16_t*)((unsigned char*)args.out + DO_XN), (const bf16_t*)(ws + WS_W1T), MPAD, N1, 1024, 1024, 1024, 0}; pg8::StaticOrder S; S.init(MPAD, N1, G, (int)blockIdx.x);
        pg8::EpiProj E{PROJ, mgq_lo, mgq_hi, (float*)(ws + WS_GATES), (const float*)(ws + WS_BIAS1), (bf16_t*)(ws + WS_HALO)};
        pg8::gemm_phase<pg8::EpiProj, pg8::StaticOrder, true, true>((PG8_LAS unsigned char*)lds, g, S, E); }
    SEAM(1);
    if (IN(2)) { conv_phase(args, gw, NGW, lane); xcd_barrier(bar); }
    if (IN(2)) {   volatile int* QCTL = (volatile int*)(lds + LDS_BARST - 32);
#define Q_NEXT(u_) do { __syncthreads(); if (tid == 0) QCTL[0] = (int)atomicAdd((unsigned*)ws, 1u); __syncthreads(); u_ = QCTL[0]; } while (0)
        int u; Q_NEXT(u);
        while (u < ML_NSEGU) { mlstm_segment(args, lds, tid, u);
            const int sid = u < 128 ? (u >> 3) : 16 + ((u - 128) >> 2); const unsigned nseg = u < 128 ? 8u : 4u;
            if (tid == 0) QCTL[1] = (__hip_atomic_fetch_add((unsigned*)(ws + WS_SEGCNT) + sid, 1u, __ATOMIC_RELAXED, __HIP_MEMORY_SCOPE_AGENT) == nseg - 1u) ? 1 : 0;
            __syncthreads();
            if (QCTL[1]) { __builtin_amdgcn_fence(__ATOMIC_ACQUIRE, "agent"); asm volatile("s_waitcnt vmcnt(0)" ::: "memory"); mlstm_chain(args, tid, sid); }
            Q_NEXT(u); }
        while (u < ML_NSEGU + NA_UNITS) { na_unit(args, lds, tid, u - ML_NSEGU); Q_NEXT(u); }
#undef Q_NEXT
    }
    SEAM(2);
    if (IN(3)) mlstm_finish(args, lds, tid);
    SEAM(3);
    if (IN(4)) {   pg8::StaticOrder S; S.init(NTOK, 1024, G, (int)blockIdx.x);
        { pg8::Gemm g{PROJ + C_YA, (const bf16_t*)(ws + WS_WAT), NTOK, 1024, 512, LDP, 512, 1}; pg8::EpiMix<false> E{PROJ + C_MIX, mgq_lo, mgq_hi};
          pg8::gemm_phase<pg8::EpiMix<false>, pg8::StaticOrder, true, true>((PG8_LAS unsigned char*)lds, g, S, E); }
        __syncthreads();
        { pg8::Gemm g{PROJ + C_YB, (const bf16_t*)(ws + WS_WBT), NTOK, 1024, 512, LDP, 512, 1}; pg8::EpiMix<true> E{PROJ + C_MIX, mgq_lo, mgq_hi};
          pg8::gemm_phase<pg8::EpiMix<true>, pg8::StaticOrder, true, true>((PG8_LAS unsigned char*)lds, g, S, E); } }
    SEAM(4);
    if (IN(5)) {   pg8::Gemm g{PROJ + C_MIX, (const bf16_t*)(ws + WS_WOT), NTOK, 1024, 1024, LDP, 1024, 0}; pg8::StaticOrder S; S.init(NTOK, 1024, G, (int)blockIdx.x);
        pg8::EpiY E{PROJ + C_Y, (float*)(ws + WS_SS)};
        pg8::gemm_phase<pg8::EpiY, pg8::StaticOrder, true, true>((PG8_LAS unsigned char*)lds, g, S, E); }
    SEAM(5);
    if (IN(6)) phase_out(args, gw, NGW, lane);
#undef IN
#undef SEAM
}

extern "C" void kernel_launch(void* const* d_in, const int*  , int n_in, void* d_out, int out_size, void* d_ws, size_t ws_size, hipStream_t stream) {
    static int grid = 0;
    if (grid == 0) {
        if (n_in != 13 || out_size != NTOK * DM || ws_size < WS_END) { fprintf(stderr, "kernel_launch: unexpected shapes (n_in %d, out %d, ws %zu, need %zu)\n", n_in, out_size, ws_size, (size_t)WS_END); grid = -1; return; }
        int dev = 0, cus = 0, per_cu = 0;
        if (hipGetDevice(&dev) != hipSuccess || hipDeviceGetAttribute(&cus, hipDeviceAttributeMultiprocessorCount, dev) != hipSuccess) { fprintf(stderr, "kernel_launch: device query failed\n"); grid = -1; return; }
        if (hipFuncSetAttribute((const void*)hybrid_fwd, hipFuncAttributeMaxDynamicSharedMemorySize, LDS_BYTES) != hipSuccess) { fprintf(stderr, "kernel_launch: hipFuncSetAttribute failed\n"); grid = -1; return; }
        if (hipOccupancyMaxActiveBlocksPerMultiprocessor(&per_cu, (const void*)hybrid_fwd, NTHREADS, LDS_BYTES) != hipSuccess || per_cu < 1) { fprintf(stderr, "kernel_launch: occupancy query says %d\n", per_cu); per_cu = 1; }
        (void)hipGetLastError();
        grid = cus;
    }
    if (grid < 0) return;
    if (hipMemsetAsync(d_ws, 0, WS_CTL_ZERO, stream) != hipSuccess) { fprintf(stderr, "kernel_launch: hipMemsetAsync failed\n"); return; }
    Args a{};
    for (int i = 0; i < 13; ++i) a.in[i] = (const float*)d_in[i];
    a.out = (float*)d_out; a.ws = (unsigned char*)d_ws; a.ph_lo = 0; a.ph_hi = 7; a.coop = 1;
    void* kargs[] = {&a};
    const hipError_t e = hipLaunchCooperativeKernel((const void*)hybrid_fwd, dim3(grid), dim3(NTHREADS), kargs, LDS_BYTES, stream);
    if (e != hipSuccess) fprintf(stderr, "cooperative launch failed: %s (grid %d)\n", hipGetErrorString(e), grid);
}
```

```cpp
#include <hip/hip_runtime.h>
#include <hip/hip_cooperative_groups.h>
#include <cstdio>
#include <cstdint>
namespace cg = cooperative_groups;
namespace pg8 {
#define PG8_LAS __attribute__((address_space(3)))
typedef unsigned short bf16_t;
typedef short bf16x8 __attribute__((ext_vector_type(8)));
typedef float f32x4 __attribute__((ext_vector_type(4)));
typedef unsigned u32x4 __attribute__((ext_vector_type(4)));
constexpr int BM = 256, BK = 64, HALF = 128, HTB = HALF * BK * 2  , NXCD = 8, WGM = 8;

__host__ __device__ __forceinline__ int lds_byte(int r, int c) { const int st = (r >> 4) * 2 + (c >> 5), rr = r & 15, cc = c & 31, ob = rr * 64 + cc * 2; return st * 1024 + (ob ^ (((ob >> 9) & 1) << 5)); }
__host__ __device__ __forceinline__ void stage_rc(int b, int& R, int& C) { const int st = b / 1024, sb = b % 1024, swz = sb ^ (((sb >> 9) & 1) << 5); R = (st >> 1) * 16 + swz / 64; C = (st & 1) * 32 + (swz % 64) / 2; }
__host__ __device__ __forceinline__ int perm32(int rho) { const int n = rho >> 4, i = rho & 15; return 8 * (i >> 2) + 4 * n + (i & 3); }

struct Unit { int pm, pn; };
struct Gemm { const bf16_t* A; const bf16_t* Bt; int M, N, K, lda, ldb, tok; };
__host__ __device__ __forceinline__ int tok_tile_row(int pm) { const int b = pm < 128 ? (pm >> 4) : 8 + ((pm - 128) >> 5); return pm * 256 + 64 * (b + 1); }
__host__ __device__ __forceinline__ size_t a_tile_row(const Gemm& g, int pm) { return (size_t)(g.tok ? tok_tile_row(pm) : pm * 256); }

struct StaticOrder {
    int nM, nN, nwg, G, c;
    __host__ __device__ void init(int M, int N, int G_, int c_) { nM = M / BM; nN = N / BM; nwg = nM * nN; G = G_; c = c_; }
    __host__ __device__ bool next(int i, Unit& u) const {
        const long L = (long)i * G + c; if (L >= nwg) return false;
        int wgid = (int)L; { const int q = nwg / NXCD, r = nwg % NXCD, xcd = wgid % NXCD, off = wgid / NXCD; wgid = (xcd < r ? xcd * (q + 1) : r * (q + 1) + (xcd - r) * q) + off; }
        const int nig = WGM * nN, gid = wgid / nig, fm = gid * WGM, gsz = (nM - fm) < WGM ? (nM - fm) : WGM;
        u.pm = fm + ((wgid % nig) % gsz); u.pn = (wgid % nig) / gsz; return true;
    }
    __device__ __forceinline__ void a_ready(const Unit&) const {}
    __device__ __forceinline__ void done(const Unit&) const {}
};

__device__ __forceinline__ unsigned cvt_pk_bf16(float lo, float hi) { unsigned r; asm volatile("v_cvt_pk_bf16_f32 %0, %1, %2" : "=v"(r) : "v"(lo), "v"(hi)); return r; }
typedef unsigned u32x2 __attribute__((ext_vector_type(2)));
__device__ __forceinline__ float bf2f(unsigned u16) { return __uint_as_float(u16 << 16); }
__device__ __forceinline__ float sigmoidf_(float x) { return __builtin_amdgcn_rcpf(1.0f + __builtin_amdgcn_exp2f(x * -1.4426950408889634f)); }
constexpr int P1_NT_PROJ = 18, P1_NT_MG = 8;
constexpr int LDP = 4608;
constexpr int MGQ_SPLIT_ROW = 48384;

struct EpiProj {
    static constexpr bool PERM = true, AFTER_DRAIN = false;
    bf16_t* proj; unsigned char* mgq_lo; unsigned char* mgq_hi; float* gates; const float* bias; bf16_t* halo;
    __device__ __forceinline__ void operator()(const f32x4 (&acc)[2][2][4][2], const Unit& u, int wr, int wc, int fr, int fq) const {
        const int row0 = u.pm * BM + wr * 64 + fr; const int cl = wc * 32 + 8 * fq; const int bcol0 = u.pn * BM + cl;
        f32x4 bv[2][2];
#pragma unroll
        for (int bj = 0; bj < 2; ++bj)
#pragma unroll
            for (int n = 0; n < 2; ++n) bv[bj][n] = *(const f32x4*)(bias + bcol0 + bj * HALF + 4 * n);
        if (u.pn < P1_NT_PROJ) {
#pragma unroll
            for (int ai = 0; ai < 2; ++ai)
#pragma unroll
                for (int m = 0; m < 4; ++m) { bf16_t* rowp = proj + (size_t)(row0 + ai * HALF + m * 16) * LDP + bcol0;
#pragma unroll
                    for (int bj = 0; bj < 2; ++bj) { const f32x4 v0 = acc[ai][bj][m][0] + bv[bj][0], v1 = acc[ai][bj][m][1] + bv[bj][1];
                        u32x4 w; w.x = cvt_pk_bf16(v0[0], v0[1]); w.y = cvt_pk_bf16(v0[2], v0[3]); w.z = cvt_pk_bf16(v1[0], v1[1]); w.w = cvt_pk_bf16(v1[2], v1[3]);
                        *(u32x4*)(rowp + bj * HALF) = w;
                        if (u.pn >= 8 && u.pn < 12 && ((m == 0 && fr == 0) || (m == 3 && fr == 15)))
                            *(u32x4*)(halo + ((size_t)((row0 + ai * HALF + m * 16) >> 6) * 2 + (m == 3 ? 1 : 0)) * 1024 + (u.pn - 8) * BM + cl + bj * HALF) = w; } }
        } else if (u.pn < P1_NT_PROJ + P1_NT_MG) {
            const int gc0 = (u.pn - P1_NT_PROJ) * BM + cl;
#pragma unroll
            for (int ai = 0; ai < 2; ++ai)
#pragma unroll
                for (int m = 0; m < 4; ++m) { const int row = row0 + ai * HALF + m * 16;
                    unsigned char* rowp = (row < MGQ_SPLIT_ROW ? mgq_lo + (size_t)row * 2048 : mgq_hi + (size_t)(row - MGQ_SPLIT_ROW) * 2048) + gc0;
#pragma unroll
                    for (int bj = 0; bj < 2; ++bj) { const f32x4 v0 = acc[ai][bj][m][0] + bv[bj][0], v1 = acc[ai][bj][m][1] + bv[bj][1];
                        u32x2 w; w.x = 0u; w.y = 0u;
                        w.x = __builtin_amdgcn_cvt_pk_u8_f32(sigmoidf_(v0[0]) * 255.0f, 0, w.x); w.x = __builtin_amdgcn_cvt_pk_u8_f32(sigmoidf_(v0[1]) * 255.0f, 1, w.x);
                        w.x = __builtin_amdgcn_cvt_pk_u8_f32(sigmoidf_(v0[2]) * 255.0f, 2, w.x); w.x = __builtin_amdgcn_cvt_pk_u8_f32(sigmoidf_(v0[3]) * 255.0f, 3, w.x);
                        w.y = __builtin_amdgcn_cvt_pk_u8_f32(sigmoidf_(v1[0]) * 255.0f, 0, w.y); w.y = __builtin_amdgcn_cvt_pk_u8_f32(sigmoidf_(v1[1]) * 255.0f, 1, w.y);
                        w.y = __builtin_amdgcn_cvt_pk_u8_f32(sigmoidf_(v1[2]) * 255.0f, 2, w.y); w.y = __builtin_amdgcn_cvt_pk_u8_f32(sigmoidf_(v1[3]) * 255.0f, 3, w.y);
                        *(u32x2*)(rowp + bj * HALF) = w; } }
        } else {
            if (wc == 0 && fq < 2) {
#pragma unroll
                for (int ai = 0; ai < 2; ++ai)
#pragma unroll
                    for (int m = 0; m < 4; ++m) { float* gp = gates + (size_t)(row0 + ai * HALF + m * 16) * 16 + 8 * fq;
                        *(f32x4*)(gp) = acc[ai][0][m][0] + bv[0][0]; *(f32x4*)(gp + 4) = acc[ai][0][m][1] + bv[0][1]; }
            }
        }
    }
};
__device__ __forceinline__ const unsigned char* mgq_row(const unsigned char* lo, const unsigned char* hi, int row) { return row < MGQ_SPLIT_ROW ? lo + (size_t)row * 2048 : hi + (size_t)(row - MGQ_SPLIT_ROW) * 2048; }
template <bool SECOND> struct EpiMix {
    static constexpr bool PERM = true, AFTER_DRAIN = false;
    bf16_t* mix; const unsigned char* mgq_lo; const unsigned char* mgq_hi;
    __device__ __forceinline__ void operator()(const f32x4 (&acc)[2][2][4][2], const Unit& u, int wr, int wc, int fr, int fq) const {
        const int row0 = u.pm * BM + wr * 64 + fr; const int col0 = u.pn * BM + wc * 32 + 8 * fq;
#pragma unroll
        for (int ai = 0; ai < 2; ++ai)
#pragma unroll
            for (int m = 0; m < 4; ++m) { const int row = row0 + ai * HALF + m * 16; bf16_t* rowp = mix + (size_t)row * LDP + col0;
                const unsigned char* gp = mgq_row(mgq_lo, mgq_hi, row + tok_tile_row(u.pm) - u.pm * BM) + (SECOND ? 1024 : 0) + col0;
#pragma unroll
                for (int bj = 0; bj < 2; ++bj) { const u32x2 gq = *(const u32x2*)(gp + bj * HALF); float g[8];
#pragma unroll
                    for (int e = 0; e < 4; ++e) { g[e] = (float)((gq.x >> (8 * e)) & 255u) * (1.0f / 255.0f); g[4 + e] = (float)((gq.y >> (8 * e)) & 255u) * (1.0f / 255.0f); }
                    float v[8];
#pragma unroll
                    for (int e = 0; e < 4; ++e) { v[e] = acc[ai][bj][m][0][e] * g[e]; v[4 + e] = acc[ai][bj][m][1][e] * g[4 + e]; }
                    if (SECOND) { const u32x4 old = *(const u32x4*)(rowp + bj * HALF);
                        v[0] += bf2f(old.x & 0xffffu); v[1] += bf2f(old.x >> 16); v[2] += bf2f(old.y & 0xffffu); v[3] += bf2f(old.y >> 16);
                        v[4] += bf2f(old.z & 0xffffu); v[5] += bf2f(old.z >> 16); v[6] += bf2f(old.w & 0xffffu); v[7] += bf2f(old.w >> 16); }
                    u32x4 w; w.x = cvt_pk_bf16(v[0], v[1]); w.y = cvt_pk_bf16(v[2], v[3]); w.z = cvt_pk_bf16(v[4], v[5]); w.w = cvt_pk_bf16(v[6], v[7]);
                    *(u32x4*)(rowp + bj * HALF) = w; } }
    }
};
struct EpiY {
    static constexpr bool PERM = true, AFTER_DRAIN = false;
    bf16_t* y; float* ss;
    __device__ __forceinline__ void operator()(const f32x4 (&acc)[2][2][4][2], const Unit& u, int wr, int wc, int fr, int fq) const {
        const int row0 = u.pm * BM + wr * 64 + fr; const int col0 = u.pn * BM + wc * 32 + 8 * fq;
#pragma unroll
        for (int ai = 0; ai < 2; ++ai)
#pragma unroll
            for (int m = 0; m < 4; ++m) { const int row = row0 + ai * HALF + m * 16; bf16_t* rowp = y + (size_t)row * LDP + col0; float s = 0.f;
#pragma unroll
                for (int bj = 0; bj < 2; ++bj) { const f32x4 v0 = acc[ai][bj][m][0], v1 = acc[ai][bj][m][1];
                    s += (v0[0] * v0[0] + v0[1] * v0[1]) + (v0[2] * v0[2] + v0[3] * v0[3]) + (v1[0] * v1[0] + v1[1] * v1[1]) + (v1[2] * v1[2] + v1[3] * v1[3]);
                    u32x4 w; w.x = cvt_pk_bf16(v0[0], v0[1]); w.y = cvt_pk_bf16(v0[2], v0[3]); w.z = cvt_pk_bf16(v1[0], v1[1]); w.w = cvt_pk_bf16(v1[2], v1[3]);
                    *(u32x4*)(rowp + bj * HALF) = w; }
                s += __shfl_xor(s, 16); s += __shfl_xor(s, 32);
                if (fq == 0) ss[(size_t)row * 16 + u.pn * 4 + wc] = s; }
    }
};
template <class Epi, class Sched, bool ALIGN_EPI = false, bool SP2 = false>
__device__ __forceinline__ void gemm_phase(PG8_LAS unsigned char* lds, const Gemm g, const Sched& S, const Epi& E) {
    const int tid = threadIdx.x, wid = __builtin_amdgcn_readfirstlane(tid >> 6), lane = tid & 63, wr = wid >> 2, wc = wid & 3, fr = lane & 15, fq = lane >> 4;
    const int K = g.K, nt = K / BK;
    unsigned voffA[2], voffB[2];
#pragma unroll
    for (int i = 0; i < 2; ++i) { int R, C; stage_rc(tid * 16 + i * 8192, R, C); const int Rb = Epi::PERM ? ((R & ~31) + perm32(R & 31)) : R;
        voffA[i] = (unsigned)(R * g.lda + C) * 2u; voffB[i] = (unsigned)(Rb * g.ldb + C) * 2u; }
    const size_t kstep = (size_t)(BK * 2);
    const size_t hstepA = (size_t)HALF * g.lda * 2, hstepB = (size_t)HALF * g.ldb * 2;
    const size_t tstepB = 2 * hstepB;
    const unsigned ldsw = (unsigned)wid * 1024u;
    const int aoff = lds_byte(wr * 64 + fr, fq * 8), boff = lds_byte(wc * 32 + fr, fq * 8);
#define PG8_SA(b, h) (((b) * 2 + (h)) * HTB)
#define PG8_SB(b, h) ((4 + (b) * 2 + (h)) * HTB)
#define PG8_STAGE(bufoff, gbase, voff) do { _Pragma("unroll") for (int _i = 0; _i < 2; ++_i) \
        __builtin_amdgcn_global_load_lds((const unsigned*)((const char*)(gbase) + (voff)[_i]), (PG8_LAS unsigned*)(lds + (bufoff) + ldsw + _i * 8192), 16, 0, 0); } while (0)
#define PG8_LDA(dst, b, h) do { _Pragma("unroll") for (int m = 0; m < 4; ++m) _Pragma("unroll") for (int k = 0; k < 2; ++k) dst[m][k] = *(const PG8_LAS bf16x8*)(lds + PG8_SA(b, h) + aoff + m * 2048 + k * 1024); } while (0)
#define PG8_LDB(dst, b, h) do { _Pragma("unroll") for (int n = 0; n < 2; ++n) _Pragma("unroll") for (int k = 0; k < 2; ++k) dst[n][k] = *(const PG8_LAS bf16x8*)(lds + PG8_SB(b, h) + boff + n * 2048 + k * 1024); } while (0)
#define PG8_MMA(ai, bj, At, Bt) do { __builtin_amdgcn_s_setprio(1); _Pragma("unroll") for (int m = 0; m < 4; ++m) _Pragma("unroll") for (int n = 0; n < 2; ++n) _Pragma("unroll") for (int k = 0; k < 2; ++k) \
        acc[ai][bj][m][n] = __builtin_amdgcn_mfma_f32_16x16x32_bf16(Bt[n][k], At[m][k], acc[ai][bj][m][n], 0, 0, 0); __builtin_amdgcn_s_setprio(0); } while (0)
#define PG8_WAIT_V(n) asm volatile("s_waitcnt vmcnt(" #n ")" ::: "memory")
#define PG8_WAIT_L(n) asm volatile("s_waitcnt lgkmcnt(" #n ")" ::: "memory")
#define PG8_BAR __builtin_amdgcn_s_barrier()
#define PG8_SCHED __builtin_amdgcn_sched_barrier(0)
    Unit cur, nxt; int ui = 0;
    if (!S.next(0, cur)) return;
    f32x4 acc[2][2][4][2];
#pragma unroll
    for (int a = 0; a < 2; ++a)
#pragma unroll
        for (int b = 0; b < 2; ++b)
#pragma unroll
            for (int m = 0; m < 4; ++m)
#pragma unroll
                for (int n = 0; n < 2; ++n) acc[a][b][m][n] = (f32x4){0.f, 0.f, 0.f, 0.f};
    bf16x8 At[4][2], B0[2][2], B1[2][2];
    const char* cA = (const char*)g.A + a_tile_row(g, cur.pm) * (size_t)g.lda * 2; const char* cB = (const char*)g.Bt + (size_t)cur.pn * tstepB;
    S.a_ready(cur);
    if constexpr (SP2) {
        PG8_STAGE(PG8_SB(0, 0), cB, voffB); PG8_STAGE(PG8_SB(0, 1), cB + hstepB, voffB); PG8_STAGE(PG8_SA(0, 0), cA, voffA); PG8_STAGE(PG8_SA(0, 1), cA + hstepA, voffA);
        if (wr == 1) PG8_BAR;
        PG8_WAIT_V(2); PG8_BAR;
        PG8_STAGE(PG8_SB(1, 0), cB + kstep, voffB); PG8_STAGE(PG8_SA(1, 0), cA + kstep, voffA); PG8_STAGE(PG8_SB(1, 1), cB + hstepB + kstep, voffB);
        PG8_WAIT_V(6); PG8_BAR;
    } else {
        PG8_STAGE(PG8_SB(0, 0), cB, voffB); PG8_STAGE(PG8_SA(0, 0), cA, voffA); PG8_STAGE(PG8_SB(0, 1), cB + hstepB, voffB); PG8_STAGE(PG8_SA(0, 1), cA + hstepA, voffA);
        if (wr == 1) PG8_BAR;
        PG8_WAIT_V(4); PG8_BAR;
        PG8_STAGE(PG8_SB(1, 0), cB + kstep, voffB); PG8_STAGE(PG8_SA(1, 0), cA + kstep, voffA); PG8_STAGE(PG8_SB(1, 1), cB + hstepB + kstep, voffB);
        PG8_WAIT_V(6); PG8_BAR;
    }
    for (;;) {
        const bool has_next = S.next(ui + 1, nxt);
        const char* nA = has_next ? (const char*)g.A + a_tile_row(g, nxt.pm) * (size_t)g.lda * 2 : cA; const char* nB = has_next ? (const char*)g.Bt + (size_t)nxt.pn * tstepB : cB;
        for (int t = 0; t < nt; t += 2) {
            const bool last = (t == nt - 2);
            const char* a1 = cA + (size_t)(t + 1) * kstep;
            const char* a2 = last ? nA : cA + (size_t)(t + 2) * kstep; const char* b2 = last ? nB : cB + (size_t)(t + 2) * kstep;
            const char* a3 = a2 + kstep; const char* b3 = b2 + kstep;
            if (last && has_next) S.a_ready(nxt);
            if constexpr (SP2) {
            PG8_LDB(B0, 0, 0); PG8_LDB(B1, 0, 1); PG8_SCHED; PG8_LDA(At, 0, 0); PG8_STAGE(PG8_SA(1, 1), a1 + hstepA, voffA);
            PG8_WAIT_V(8); PG8_WAIT_L(0); PG8_BAR; PG8_MMA(0, 0, At, B0); PG8_MMA(0, 1, At, B1); PG8_BAR; PG8_SCHED;
            PG8_LDA(At, 0, 1); PG8_STAGE(PG8_SB(0, 0), b2, voffB); PG8_STAGE(PG8_SB(0, 1), b2 + hstepB, voffB); PG8_STAGE(PG8_SA(0, 0), a2, voffA);
            PG8_WAIT_V(8); PG8_WAIT_L(0); PG8_BAR; PG8_MMA(1, 0, At, B0); PG8_MMA(1, 1, At, B1); PG8_BAR; PG8_SCHED;
            PG8_LDB(B0, 1, 0); PG8_LDB(B1, 1, 1); PG8_SCHED; PG8_LDA(At, 1, 0); PG8_STAGE(PG8_SA(0, 1), a2 + hstepA, voffA);
            PG8_WAIT_V(8); PG8_WAIT_L(0); PG8_BAR; PG8_MMA(0, 0, At, B0); PG8_MMA(0, 1, At, B1); PG8_BAR; PG8_SCHED;
            PG8_LDA(At, 1, 1); PG8_STAGE(PG8_SB(1, 0), b3, voffB); PG8_STAGE(PG8_SB(1, 1), b3 + hstepB, voffB); PG8_STAGE(PG8_SA(1, 0), a3, voffA);
            PG8_WAIT_V(8); PG8_WAIT_L(0); PG8_BAR; PG8_MMA(1, 0, At, B0); PG8_MMA(1, 1, At, B1); PG8_BAR; PG8_SCHED;
            } else {
            PG8_LDB(B0, 0, 0); PG8_SCHED; PG8_LDA(At, 0, 0); PG8_STAGE(PG8_SA(1, 1), a1 + hstepA, voffA);
            PG8_WAIT_L(8); PG8_BAR; PG8_WAIT_L(0); PG8_MMA(0, 0, At, B0); PG8_BAR; PG8_SCHED;
            PG8_LDB(B1, 0, 1); PG8_STAGE(PG8_SB(0, 0), b2, voffB);
            PG8_BAR; PG8_WAIT_L(0); PG8_MMA(0, 1, At, B1); PG8_BAR;
            PG8_LDA(At, 0, 1); PG8_STAGE(PG8_SA(0, 0), a2, voffA);
            PG8_BAR; PG8_WAIT_L(0); PG8_MMA(1, 0, At, B0); PG8_BAR; PG8_SCHED;
            PG8_STAGE(PG8_SB(0, 1), b2 + hstepB, voffB);
            PG8_WAIT_V(6); PG8_BAR; PG8_MMA(1, 1, At, B1); PG8_BAR;
            PG8_LDB(B0, 1, 0); PG8_SCHED; PG8_LDA(At, 1, 0); PG8_STAGE(PG8_SA(0, 1), a2 + hstepA, voffA);
            PG8_WAIT_L(8); PG8_BAR; PG8_WAIT_L(0); PG8_MMA(0, 0, At, B0); PG8_BAR; PG8_SCHED;
            PG8_LDB(B1, 1, 1); PG8_STAGE(PG8_SB(1, 0), b3, voffB);
            PG8_BAR; PG8_WAIT_L(0); PG8_MMA(0, 1, At, B1); PG8_BAR;
            PG8_LDA(At, 1, 1); PG8_STAGE(PG8_SA(1, 0), a3, voffA);
            PG8_BAR; PG8_WAIT_L(0); PG8_MMA(1, 0, At, B0); PG8_BAR; PG8_SCHED;
            PG8_STAGE(PG8_SB(1, 1), b3 + hstepB, voffB);
            PG8_WAIT_V(6); PG8_BAR; PG8_MMA(1, 1, At, B1); PG8_BAR;
            }
        }
        if constexpr (ALIGN_EPI) { if (wr == 0) PG8_BAR; }
        if constexpr (!Epi::AFTER_DRAIN) { E(acc, cur, wr, wc, fr, fq); S.done(cur); }
        if (!has_next) break;
#pragma unroll
        for (int a = 0; a < 2; ++a)
#pragma unroll
            for (int b = 0; b < 2; ++b)
#pragma unroll
                for (int m = 0; m < 4; ++m)
#pragma unroll
                    for (int n = 0; n < 2; ++n) acc[a][b][m][n] = (f32x4){0.f, 0.f, 0.f, 0.f};
        cur = nxt; cA = nA; cB = nB; ++ui;
        if constexpr (ALIGN_EPI) { if (wr == 1) PG8_BAR; }
    }
    PG8_WAIT_V(0);
    if constexpr (!ALIGN_EPI) { if (wr == 0) PG8_BAR; }
    PG8_BAR;
    if constexpr (Epi::AFTER_DRAIN) { E.fused(acc, cur, wr, wc, fr, fq, lds, wid, lane); S.done(cur); }
#undef PG8_SA
#undef PG8_SB
#undef PG8_STAGE
#undef PG8_LDA
#undef PG8_LDB
#undef PG8_MMA
#undef PG8_WAIT_V
#undef PG8_WAIT_L
#undef PG8_BAR
#undef PG8_SCHED
}
}
using pg8::bf16_t; using pg8::LDP; using pg8::bf2f; using pg8::sigmoidf_;
typedef float f32x4 __attribute__((ext_vector_type(4)));
typedef unsigned u32x4 __attribute__((ext_vector_type(4)));
typedef unsigned u32x2 __attribute__((ext_vector_type(2)));
typedef short bf16x8 __attribute__((ext_vector_type(8)));
#define LAS __attribute__((address_space(3)))
#define LDS_BARRIER() do { asm volatile("s_waitcnt lgkmcnt(0)" ::: "memory"); __builtin_amdgcn_s_barrier(); asm volatile("" ::: "memory"); } while (0)
constexpr int NWAVES = 8, NTHREADS = 512;
constexpr int DM = 1024, NPROMPT = 8, TP = 4096, TS = 8192, LPP = 4160, LPS = 8256;
constexpr int ROWS_P = NPROMPT * LPP;
constexpr int MROWS = ROWS_P + 2 * LPS;
constexpr int MPAD = 49920;
constexpr int NTOK = 49152;
constexpr int NIN = 6672, N1 = 6912;
constexpr int C_NAQ = 0, C_NAK = 512, C_NAV = 1024, C_NAZ = 1536, C_MLQ = 2048, C_MLK = 2560, C_MLV = 3072, C_MLZ = 3584, C_MLO = 4096;
constexpr int C_YA = 0, C_YB = 3072, C_MIX = 2048, C_Y = 1024;
constexpr float EPS = 1e-6f;
constexpr size_t MiB = 1u << 20;
constexpr size_t WS_W1T = 2 * MiB;
constexpr size_t WS_WAT = 16 * MiB, WS_WBT = 17 * MiB, WS_WOT = 18 * MiB;
constexpr size_t WS_BIAS1 = 20 * MiB;
constexpr size_t WS_GATES = 21 * MiB;
constexpr size_t WS_SS = 25 * MiB;
constexpr size_t WS_HALO = 28 * MiB + 512 * 1024;
constexpr size_t WS_PROJ = 32 * MiB;
constexpr size_t WS_MGQ_HI = WS_PROJ + (size_t)MPAD * LDP * 2;
constexpr size_t WS_MGQ_END = WS_MGQ_HI + (size_t)(MPAD - pg8::MGQ_SPLIT_ROW) * 2048;
constexpr size_t WS_SEGX = 474 * MiB, WS_START = 486 * MiB;
constexpr size_t WS_SEGN = 498 * MiB, WS_STARTN = 498 * MiB + 512 * 1024;
constexpr size_t WS_MLROWS = 499 * MiB;
constexpr size_t WS_END = WS_MLROWS + (size_t)MROWS * 32 * 4;
static_assert(WS_MGQ_END <= WS_SEGX && WS_END <= 512 * MiB, "d_ws map");
constexpr size_t DO_XN = 0, DO_HF = 0, DO_HB = (size_t)MPAD * 512 * 2, DO_MGQ_LO = (size_t)MPAD * 1024 * 2;
static_assert(DO_MGQ_LO + (size_t)pg8::MGQ_SPLIT_ROW * 2048 <= (size_t)49152 * 1024 * 4, "d_out map");
constexpr int LDS_BYTES = 163840;
constexpr size_t WS_BAR = 65536;
constexpr size_t WS_SEGCNT = 8192;
constexpr size_t WS_CTL_ZERO = 131072;
constexpr int LDS_BARST = LDS_BYTES - 64;

struct Args { const float* in[13]; float* out; unsigned char* ws; int ph_lo, ph_hi, coop, pad; };

__device__ __forceinline__ unsigned f2bf(float f) { unsigned u = __float_as_uint(f); return (u + 0x7fffu + ((u >> 16) & 1u)) >> 16; }
typedef __bf16 bf16v2_t __attribute__((ext_vector_type(2)));
typedef float f32v2_t __attribute__((ext_vector_type(2)));
__device__ __forceinline__ unsigned pk2(float lo, float hi) { const f32v2_t v = {lo, hi}; const bf16v2_t b = __builtin_convertvector(v, bf16v2_t); return __builtin_bit_cast(unsigned, b); }
__device__ __forceinline__ float siluf_(float x) { return x * __builtin_amdgcn_rcpf(1.0f + __expf(-x)); }
__device__ __forceinline__ float wave_sum(float v) {
#pragma unroll
    for (int o = 1; o < 64; o <<= 1) v += __shfl_xor(v, o);
    return v;
}
__device__ __forceinline__ float wave_max(float v) {
#pragma unroll
    for (int o = 1; o < 64; o <<= 1) v = fmaxf(v, __shfl_xor(v, o));
    return v;
}
__device__ __forceinline__ void row_info(int m, int& b, int& p) {
    if (m < ROWS_P) { b = m / LPP; p = m - b * LPP; }
    else if (m < MROWS) { const int r = m - ROWS_P; const int bb = r / LPS; b = NPROMPT + bb; p = r - bb * LPS; }
    else { b = -1; p = 0; }
}
__device__ __forceinline__ int seq_base(int b) { return b < NPROMPT ? b * LPP : ROWS_P + (b - NPROMPT) * LPS; }
__device__ __forceinline__ int seq_lp(int b) { return b < NPROMPT ? LPP : LPS; }

__device__ __forceinline__ void p0_transpose_item(const float* W, int Nsrc, int K, bf16_t* WT, int src_n0, int dst_row0, int nvalid, int k0, float* scr, int lane) {
#pragma unroll 8
    for (int i = 0; i < 32; ++i) { const int kk = 2 * i + (lane >> 5), n = lane & 31; scr[kk * 33 + n] = (n < nvalid) ? W[(size_t)(k0 + kk) * Nsrc + src_n0 + n] : 0.f; }
    asm volatile("s_waitcnt lgkmcnt(0)" ::: "memory");
    const int c = lane & 7;
#pragma unroll
    for (int j = 0; j < 4; ++j) { const int n = (lane >> 3) + 8 * j; const float* s = scr + (8 * c) * 33 + n;
        u32x4 o; o.x = pk2(s[0 * 33], s[1 * 33]); o.y = pk2(s[2 * 33], s[3 * 33]); o.z = pk2(s[4 * 33], s[5 * 33]); o.w = pk2(s[6 * 33], s[7 * 33]);
        *(u32x4*)(WT + (size_t)(dst_row0 + n) * K + k0 + 8 * c) = o; }
    asm volatile("s_waitcnt lgkmcnt(0)" ::: "memory");
}
__device__ __forceinline__ void phase0(const Args& a, unsigned char* lds, int gw, int NGW, int wave, int lane) {
    const float* w_in = a.in[4]; const float* b_in = a.in[5]; const float* w_a = a.in[9]; const float* w_b = a.in[10]; const float* w_out = a.in[11];
    bf16_t* W1T = (bf16_t*)(a.ws + WS_W1T); bf16_t* WAT = (bf16_t*)(a.ws + WS_WAT); bf16_t* WBT = (bf16_t*)(a.ws + WS_WBT); bf16_t* WOT = (bf16_t*)(a.ws + WS_WOT);
    float* scr = (float*)(lds + wave * 16384);
    constexpr int I_A = 144 * 16, I_MG = 64 * 16, I_G = 16, I_WA = 32 * 8, I_WB = 32 * 8, I_WO = 32 * 16, NITEMS = I_A + I_MG + I_G + I_WA + I_WB + I_WO;
    for (int it = gw; it < NITEMS; it += NGW) {
        int r = it;
        if (r < I_A) { p0_transpose_item(w_in, NIN, 1024, W1T, (r % 144) * 32, (r % 144) * 32, 32, (r / 144) * 64, scr, lane); continue; } r -= I_A;
        if (r < I_MG) { p0_transpose_item(w_in, NIN, 1024, W1T, 4624 + (r % 64) * 32, 4608 + (r % 64) * 32, 32, (r / 64) * 64, scr, lane); continue; } r -= I_MG;
        if (r < I_G) { p0_transpose_item(w_in, NIN, 1024, W1T, 4608, 6656, 16, r * 64, scr, lane); continue; } r -= I_G;
        if (r < I_WA) { p0_transpose_item(w_a, 1024, 512, WAT, (r % 32) * 32, (r % 32) * 32, 32, (r / 32) * 64, scr, lane); continue; } r -= I_WA;
        if (r < I_WB) { p0_transpose_item(w_b, 1024, 512, WBT, (r % 32) * 32, (r % 32) * 32, 32, (r / 32) * 64, scr, lane); continue; } r -= I_WB;
        p0_transpose_item(w_out, 1024, 1024, WOT, (r % 32) * 32, (r % 32) * 32, 32, (r / 32) * 64, scr, lane);
    }
    for (int i = gw * 64 + lane; i < (N1 - 6688) * 1024 / 8; i += NGW * 64) ((u32x4*)(W1T + (size_t)6688 * 1024))[i] = (u32x4){0u, 0u, 0u, 0u};
    float* bias1 = (float*)(a.ws + WS_BIAS1);
    for (int c = gw * 64 + lane; c < N1; c += NGW * 64) bias1[c] = c < 4608 ? b_in[c] : (c < 6656 ? b_in[4624 + (c - 4608)] : (c < 6672 ? b_in[4608 + (c - 6656)] : 0.f));
    const float* xp = a.in[0]; const float* xs = a.in[1]; const float* meta = a.in[2]; const float* g_pre = a.in[3];
    bf16_t* XN = (bf16_t*)((unsigned char*)a.out + DO_XN);
    f32x4 gv[4];
#pragma unroll
    for (int j = 0; j < 4; ++j) gv[j] = ((const f32x4*)g_pre)[lane + 64 * j];
    for (int m = gw; m < MPAD; m += NGW) {
        int b, p; row_info(m, b, p);
        unsigned long long* o8 = (unsigned long long*)(XN + (size_t)m * DM) + lane;
        if (b < 0 || p < 48) {
#pragma unroll
            for (int j = 0; j < 4; ++j) o8[64 * j] = 0ull;
            continue; }
        const float* src = p < 64 ? meta + (size_t)(p - 48) * DM : (b < NPROMPT ? xp + ((size_t)b * TP + (p - 64)) * DM : xs + ((size_t)(b - NPROMPT) * TS + (p - 64)) * DM);
        f32x4 v[4]; float s = 0.f;
#pragma unroll
        for (int j = 0; j < 4; ++j) { v[j] = __builtin_nontemporal_load((const f32x4*)src + lane + 64 * j); s += (v[j].x * v[j].x + v[j].y * v[j].y) + (v[j].z * v[j].z + v[j].w * v[j].w); }
        const float rstd = rsqrtf(wave_sum(s) * (1.f / DM) + EPS);
#pragma unroll
        for (int j = 0; j < 4; ++j) { const f32x4 y = v[j] * rstd * gv[j]; o8[64 * j] = (unsigned long long)pk2(y.x, y.y) | ((unsigned long long)pk2(y.z, y.w) << 32); }
    }
}

__device__ __forceinline__ void unpack8(const u32x4 r, float (&x)[8]) {
    x[0] = bf2f(r.x & 0xffffu); x[1] = bf2f(r.x >> 16); x[2] = bf2f(r.y & 0xffffu); x[3] = bf2f(r.y >> 16);
    x[4] = bf2f(r.z & 0xffffu); x[5] = bf2f(r.z >> 16); x[6] = bf2f(r.w & 0xffffu); x[7] = bf2f(r.w >> 16);
}

__device__ __forceinline__ void conv_phase(const Args& a, int gw, int NGW, int lane) {
    bf16_t* PROJ = (bf16_t*)(a.ws + WS_PROJ); const bf16_t* HALO = (const bf16_t*)(a.ws + WS_HALO); const float* cw = a.in[7];
    for (int it = gw; it < (MROWS / 64) * 2; it += NGW) {
        const int ci = it >> 1, half = it & 1, ch = half * 512 + 8 * lane;
        int b, p0; row_info(ci * 64, b, p0); const int Lp = seq_lp(b);
        float w0[8], w1[8], w2[8];
#pragma unroll
        for (int e = 0; e < 8; ++e) { w0[e] = cw[ch + e]; w1[e] = cw[1024 + ch + e]; w2[e] = cw[2048 + ch + e]; }
        const float sc = half ? 0.08838834764831845f : 1.0f;
        const u32x4 z4 = (u32x4){0u, 0u, 0u, 0u};
        u32x4 prev = (p0 == 0) ? z4 : *(const u32x4*)(HALO + ((size_t)(ci - 1) * 2 + 1) * 1024 + ch);
        bf16_t* colp = PROJ + (size_t)ci * 64 * LDP + C_MLQ + ch;
        for (int bt = 0; bt < 4; ++bt) {
            u32x4 cur[16];
#pragma unroll
            for (int e = 0; e < 16; ++e) { cur[e] = *(const u32x4*)(colp + (size_t)(16 * bt + e) * LDP); if (p0 + 16 * bt + e < 48) cur[e] = z4; }
            u32x4 nxt;
            if (bt < 3) { nxt = *(const u32x4*)(colp + (size_t)(16 * bt + 16) * LDP); if (p0 + 16 * bt + 16 < 48) nxt = z4; }
            else nxt = (p0 + 64 >= Lp) ? z4 : *(const u32x4*)(HALO + ((size_t)(ci + 1) * 2) * 1024 + ch);
#pragma unroll
            for (int e = 0; e < 16; ++e) { float xm[8], x0[8], xp[8], y[8];
                unpack8(e == 0 ? prev : cur[e - 1], xm); unpack8(cur[e], x0); unpack8(e == 15 ? nxt : cur[e + 1], xp);
                const bool pad = p0 + 16 * bt + e < 48;
#pragma unroll
                for (int c = 0; c < 8; ++c) { const float x = w0[c] * xm[c] + w1[c] * x0[c] + w2[c] * xp[c]; y[c] = pad ? 0.f : siluf_(x) * sc; }
                *(u32x4*)(colp + (size_t)(16 * bt + e) * LDP) = (u32x4){pk2(y[0], y[1]), pk2(y[2], y[3]), pk2(y[4], y[5]), pk2(y[6], y[7])}; }
            prev = cur[15];
        }
    }
}
__device__ __forceinline__ void phase_out(const Args& a, int gw, int NGW, int lane) {
    const bf16_t* PROJ = (const bf16_t*)(a.ws + WS_PROJ); const float* SS = (const float*)(a.ws + WS_SS); const float* g_post = a.in[12];
    const float* xp = a.in[0]; const float* xs = a.in[1];
    f32x4 gv[4];
#pragma unroll
    for (int j = 0; j < 4; ++j) gv[j] = ((const f32x4*)g_post)[lane + 64 * j];
    for (int m = gw; m < NTOK; m += NGW) {
        const size_t off = (size_t)m * DM;
        const float* src = m < NPROMPT * TP ? xp + off : xs + (off - (size_t)NPROMPT * TP * DM);
        float s = (lane < 16) ? SS[(size_t)m * 16 + lane] : 0.f; s = wave_sum(s);
        const float rstd = rsqrtf(s * (1.f / DM) + EPS);
        const u32x2* yr = (const u32x2*)(PROJ + (size_t)m * LDP + C_Y);
#pragma unroll
        for (int j = 0; j < 4; ++j) { const f32x4 xv = __builtin_nontemporal_load((const f32x4*)src + lane + 64 * j); const u32x2 yv = yr[lane + 64 * j];
            f32x4 o; o.x = xv.x + bf2f(yv.x & 0xffffu) * rstd * gv[j].x; o.y = xv.y + bf2f(yv.x >> 16) * rstd * gv[j].y; o.z = xv.z + bf2f(yv.y & 0xffffu) * rstd * gv[j].z; o.w = xv.w + bf2f(yv.y >> 16) * rstd * gv[j].w;
            __builtin_nontemporal_store(o, (f32x4*)(a.out + off) + lane + 64 * j); }
    }
}

#define XB_TMO      128
#define XB_XCNT(j)  (256  + 64 * (j))
#define XB_XSUB(j)  (1280 + 64 * (j))
#define XB_XGEN(j)  (2304 + 64 * (j))
#define XB_TOP      3328
#define XB_TOPGEN   3392
#define XCD_BAR_WORDS 3456
#define XB_SPIN_CAP (1u << 18)

__device__ __forceinline__ unsigned xb_ld(unsigned* p)              { return __hip_atomic_load(p, __ATOMIC_RELAXED, __HIP_MEMORY_SCOPE_AGENT); }
__device__ __forceinline__ unsigned xb_add(unsigned* p, unsigned v) { return __hip_atomic_fetch_add(p, v, __ATOMIC_RELAXED, __HIP_MEMORY_SCOPE_AGENT); }
__device__ __forceinline__ unsigned xb_xcc_id() { return (unsigned)__builtin_amdgcn_s_getreg((3 << 11) | 20) & 0xFu; }
#define XB_SPIN(cond, bar) do { unsigned _sp = 0; while (cond) { __builtin_amdgcn_s_sleep(1); \
    if ((++_sp & 255u) == 0u) { if (xb_ld(&(bar)[XB_TMO])) break; if (_sp > XB_SPIN_CAP) { atomicAdd(&(bar)[XB_TMO], 1u); break; } } } } while (0)

struct XcdBarrier {
    unsigned* bar; unsigned x;
    volatile LAS unsigned* st;
};

__device__ __forceinline__ XcdBarrier xcd_barrier_post(unsigned* bar, volatile LAS unsigned* st) {
    XcdBarrier b; b.bar = bar; b.x = xb_xcc_id(); b.st = st;
    if (threadIdx.x == 0) (void)xb_add(&bar[XB_XCNT(b.x)], 1u);
    return b;
}
__device__ __forceinline__ void xcd_barrier_complete(unsigned* bar, unsigned x, unsigned& nloc, unsigned& nx) {
    const unsigned G = gridDim.x * gridDim.y * gridDim.z;
    unsigned sum, cnt, mine, sp = 0u;
    for (;;) {
        sum = 0u; cnt = 0u; mine = 0u;
#pragma unroll
        for (unsigned j = 0; j < 16; ++j) { const unsigned c = xb_ld(&bar[XB_XCNT(j)]); sum += c; cnt += (c > 0u) ? 1u : 0u; mine = (j == x) ? c : mine; }
        if (sum == G) break;
        __builtin_amdgcn_s_sleep(1);
        if ((++sp & 255u) == 0u) { if (xb_ld(&bar[XB_TMO])) break; if (sp > XB_SPIN_CAP) { atomicAdd(&bar[XB_TMO], 1u); break; } }
    }
    nloc = mine > 0u ? mine : 1u; nx = cnt > 0u ? cnt : 1u;
}

__device__ __forceinline__ void xcd_barrier(const XcdBarrier& b) {
    asm volatile("s_waitcnt vmcnt(0)" ::: "memory");
    __syncthreads();
    if (threadIdx.x == 0) {
        unsigned* bar = b.bar;
        __builtin_amdgcn_s_waitcnt(0);
        unsigned nloc = b.st[0], nx = b.st[1];
        if (nloc == 0u) { xcd_barrier_complete(bar, b.x, nloc, nx); b.st[0] = nloc; b.st[1] = nx; }
        const unsigned old = xb_add(&bar[XB_XSUB(b.x)], 1u);
        const unsigned gen = old / nloc;
        if (old + 1u == (gen + 1u) * nloc) {
            __builtin_amdgcn_fence(__ATOMIC_RELEASE, "agent");
            asm volatile("s_waitcnt vmcnt(0)" ::: "memory");
            const unsigned og = xb_add(&bar[XB_TOP], 1u);
            const unsigned tg = og / nx;
            if (og + 1u == (tg + 1u) * nx) xb_add(&bar[XB_TOPGEN], 1u);
            else XB_SPIN(xb_ld(&bar[XB_TOPGEN]) == tg, bar);
            __builtin_amdgcn_fence(__ATOMIC_ACQUIRE, "agent");
            xb_add(&bar[XB_XGEN(b.x)], 1u);
            asm volatile("s_waitcnt vmcnt(0)" ::: "memory");
        } else {
            XB_SPIN(xb_ld(&bar[XB_XGEN(b.x)]) == gen, bar);
            __builtin_amdgcn_fence(__ATOMIC_ACQUIRE, "agent");
            asm volatile("s_waitcnt vmcnt(0)" ::: "memory");
        }
    }
    __syncthreads();
}

typedef short bf16x8 __attribute__((ext_vector_type(8)));
typedef float f32x16 __attribute__((ext_vector_type(16)));
constexpr int ML_PQ = 136, ML_PT = 72, ML_PC = 136;
constexpr int ML_QS = 0, ML_KS = ML_QS + 64 * ML_PQ * 2, ML_VT = ML_KS + 64 * ML_PQ * 2, ML_KT = ML_VT + 128 * ML_PT * 2, ML_CB = ML_KT + 128 * ML_PT * 2;
constexpr int ML_F32 = ML_CB + 128 * ML_PC * 2, ML_GPRE = ML_F32 + 2304 + 3072, ML_HT = ML_GPRE + 17 * 200 * 4, ML_HR = ML_HT + 64 * ML_PQ * 2, ML_VTMP = ML_HR + 1024, ML_END = ML_VTMP + 64 * ML_PQ * 2;
static_assert(ML_END <= LDS_BARST - 32, "mLSTM LDS map");
constexpr int ML_NSEGU = 16 * 8 + 64 * 4;
__device__ __forceinline__ void ml_stream_decode(int sid, int& b, int& hd, int& dir, int& nseg, int& slot0) {
    if (sid < 16) { b = 8 + (sid >> 3); hd = (sid >> 1) & 3; dir = sid & 1; nseg = 8; slot0 = sid * 8; }
    else { const int s2 = sid - 16; b = s2 >> 3; hd = (s2 >> 1) & 3; dir = s2 & 1; nseg = 4; slot0 = 128 + s2 * 4; }
}
__device__ __forceinline__ void mlstm_segment(const Args& a, unsigned char* lds, int tid, int unit) {
    const bf16_t* PROJ = (const bf16_t*)(a.ws + WS_PROJ); const float* GATES = (const float*)(a.ws + WS_GATES);
    const int lane = tid & 63, w = __builtin_amdgcn_readfirstlane(tid >> 6), l31 = lane & 31, hh = lane >> 5;
    bf16_t* Qs = (bf16_t*)(lds + ML_QS); bf16_t* Ks = (bf16_t*)(lds + ML_KS); bf16_t* VT = (bf16_t*)(lds + ML_VT); bf16_t* KT = (bf16_t*)(lds + ML_KT); bf16_t* Cb = (bf16_t*)(lds + ML_CB);
    float* Fu = (float*)(lds + ML_F32); float* Fc = Fu + 64; float* Fei = Fu + 128; float* Fwp = Fu + 256; float* Fnq = Fu + 320; float* Fn = Fu + 384; float* Fsc = Fu + 512; float* Fmt = Fu + 516; float* FL = Fu + 580;
    float* GPRE = (float*)(lds + ML_GPRE); bf16_t* HT = (bf16_t*)(lds + ML_HT); bf16_t* VTMP = (bf16_t*)(lds + ML_VTMP); f32x4* HR = (f32x4*)(lds + ML_HR);
    const int tv = w & 3, tj = w >> 2;
    {   int b, hd, dir, nseg, slot0, sid, kseg;
        if (unit < 128) { sid = unit >> 3; kseg = unit & 7; } else { sid = 16 + ((unit - 128) >> 2); kseg = (unit - 128) & 3; }
        ml_stream_decode(sid, b, hd, dir, nseg, slot0);
        const int slot = slot0 + kseg;
        const int base = seq_base(b), Lp = seq_lp(b), nc = Lp >> 6;
        const int n_begin = kseg == 0 ? 0 : 17 + 16 * (kseg - 1), n_end = 17 + 16 * kseg;
        float* ROWS = (float*)(a.ws + WS_MLROWS);
        bf16_t* H = (bf16_t*)((unsigned char*)a.out + (dir ? DO_HB : DO_HF));
        for (int i = tid; i < 128 * ML_PC * 2 / 16; i += NTHREADS) ((u32x4*)Cb)[i] = (u32x4){0u, 0u, 0u, 0u};
        if (tid < 128) Fn[tid] = 0.f;
        f32x16 X[2];
#pragma unroll
        for (int x = 0; x < 2; ++x)
#pragma unroll
            for (int i = 0; i < 16; ++i) X[x][i] = 0.f;
        float mstate = 0.f, gacc = 0.f;
        u32x4 pq[2], pk[2], pv[2];
#define ML_LOAD(n_) do { const int oc_ = dir ? nc - 1 - (n_) : (n_); \
            _Pragma("unroll") for (int i_ = 0; i_ < 2; ++i_) { const int ix_ = tid + 512 * i_, j_ = ix_ >> 4; const bf16_t* rq_ = PROJ + (size_t)(base + oc_ * 64 + (dir ? 63 - j_ : j_)) * LDP + hd * 128 + 8 * (ix_ & 15);     \
                pq[i_] = *(const u32x4*)(rq_ + C_MLQ); pk[i_] = *(const u32x4*)(rq_ + C_MLK); \
                pv[i_] = *(const u32x4*)(rq_ + C_MLV); } } while (0)
#define ML_FLUSH(n_) do { const int oc_ = dir ? nc - 1 - (n_) : (n_); \
            _Pragma("unroll") for (int i_ = 0; i_ < 2; ++i_) { const int ix_ = tid + 512 * i_, j_ = ix_ >> 4; \
                __builtin_nontemporal_store(*(const u32x4*)(HT + j_ * ML_PQ + 8 * (ix_ & 15)), (u32x4*)(H + (size_t)(base + oc_ * 64 + (dir ? 63 - j_ : j_)) * 512 + hd * 128 + 8 * (ix_ & 15))); } \
            if (w == 0) *(f32x4*)(ROWS + ((size_t)(base + oc_ * 64 + (dir ? 63 - lane : lane)) * 8 + hd * 2 + dir) * 4) = HR[lane]; } while (0)
        ML_LOAD(n_begin);
        for (int cn = n_begin + w; cn < n_end; cn += NWAVES) {
            const int oc_ = dir ? nc - 1 - cn : cn; const int p_ = oc_ * 64 + (dir ? 63 - lane : lane); const bool pad_ = p_ < 48;
            const float* gp_ = GATES + (size_t)(base + p_) * 16 + dir * 8 + hd; const float gi_ = gp_[0], gf_ = gp_[4];
            const float ig = pad_ ? -1e30f : gi_; const float lf = pad_ ? 0.f : (fminf(gf_, 0.f) - log1pf(__expf(-fabsf(gf_))));
            float bs = lf;
#pragma unroll
            for (int o = 1; o < 64; o <<= 1) { const float t = __shfl_up(bs, o); if (lane >= o) bs += t; }
            const float g = __shfl(bs, 63); const float u = ig - bs; float pm = u;
#pragma unroll
            for (int o = 1; o < 64; o <<= 1) { const float t = __shfl_up(pm, o); if (lane >= o) pm = fmaxf(pm, t); }
            const float mloc = wave_max(g + u);
            float* GP = GPRE + (cn - n_begin) * 200;
            GP[lane] = u; GP[64 + lane] = pm; GP[128 + lane] = bs; { const float umax = __shfl(pm, 63); if (lane == 0) { GP[192] = g; GP[193] = mloc; GP[194] = umax; } }
        }
        __syncthreads();
        for (int n = n_begin; n < n_end; ++n) {
            const int oc = dir ? nc - 1 - n : n;
            {
#pragma unroll
              for (int i = 0; i < 2; ++i) { const int cg = w + 8 * i; const u32x4 z4 = (u32x4){0u, 0u, 0u, 0u};
                  const int ix = tid + 512 * i, jq = ix >> 4; const bool padq = oc * 64 + (dir ? 63 - jq : jq) < 48;
                  *(u32x4*)(Qs + jq * ML_PQ + 8 * (ix & 15)) = padq ? z4 : pq[i];
                  *(u32x4*)(Ks + jq * ML_PQ + 8 * (ix & 15)) = padq ? z4 : pk[i];
                  *(u32x4*)(VTMP + jq * ML_PQ + 8 * (ix & 15)) = padq ? z4 : pv[i]; (void)cg; }
              if (w == 7) {
                  const float* GP = GPRE + (n - n_begin) * 200;
                  const float u = GP[lane], pm = GP[64 + lane], bs = GP[128 + lane], g = GP[192], mloc = GP[193], umax = GP[194];
                  const float c = fmaxf(pm, mstate);
                  Fu[lane] = __expf(u - umax); Fc[lane] = __expf(umax - c); Fei[lane] = __expf(mstate - c); Fmt[lane] = bs + c; FL[lane] = gacc + bs;
                  const float mnew = fmaxf(g + mstate, mloc);
                  Fwp[lane] = __expf(g + u - mnew); if (lane == 0) Fsc[0] = __expf(g + mstate - mnew); mstate = mnew; gacc += g;
              }
            }
            if (n + 1 < n_end) ML_LOAD(n + 1);
            LDS_BARRIER();
            if (n > n_begin) ML_FLUSH(n - 1);
            { const int s = lane; const float wp = Fwp[s], eu = Fu[s];
#pragma unroll
              for (int i = 0; i < 2; ++i) { const int cg = w + 8 * i; float kk[8]; unpack8(*(const u32x4*)(Ks + s * ML_PQ + 8 * cg), kk);
                  { const u32x4 vv = *(const u32x4*)(VTMP + s * ML_PQ + 8 * cg); bf16_t* vt = VT + (8 * cg) * ML_PT + s;
                    vt[0 * ML_PT] = (bf16_t)(vv.x & 0xffffu); vt[1 * ML_PT] = (bf16_t)(vv.x >> 16); vt[2 * ML_PT] = (bf16_t)(vv.y & 0xffffu); vt[3 * ML_PT] = (bf16_t)(vv.y >> 16);
                    vt[4 * ML_PT] = (bf16_t)(vv.z & 0xffffu); vt[5 * ML_PT] = (bf16_t)(vv.z >> 16); vt[6 * ML_PT] = (bf16_t)(vv.w & 0xffffu); vt[7 * ML_PT] = (bf16_t)(vv.w >> 16); }
#pragma unroll
                  for (int e = 0; e < 8; e += 2) { const unsigned pr = pk2(kk[e] * wp, kk[e + 1] * wp); KT[(8 * cg + e) * ML_PT + s] = (bf16_t)(pr & 0xffffu); KT[(8 * cg + e + 1) * ML_PT + s] = (bf16_t)(pr >> 16); }
                  *(u32x4*)(Ks + s * ML_PQ + 8 * cg) = (u32x4){pk2(kk[0] * eu, kk[1] * eu), pk2(kk[2] * eu, kk[3] * eu), pk2(kk[4] * eu, kk[5] * eu), pk2(kk[6] * eu, kk[7] * eu)}; }
              const int j = tid >> 3, part = tid & 7; float qv[8], d = 0.f;
#pragma unroll
              for (int q2 = 0; q2 < 2; ++q2) { unpack8(*(const u32x4*)(Qs + j * ML_PQ + 16 * part + 8 * q2), qv);
#pragma unroll
                  for (int e = 0; e < 8; ++e) d += qv[e] * Fn[16 * part + 8 * q2 + e]; }
              d += __shfl_xor(d, 1); d += __shfl_xor(d, 2); d += __shfl_xor(d, 4);
              if (part == 0) Fnq[j] = d; }
            LDS_BARRIER();
            { f32x16 acc1, acc2;
#pragma unroll
              for (int i = 0; i < 16; ++i) { acc1[i] = 0.f; acc2[i] = 0.f; }
              float den1 = 0.f; const int jcol = 32 * tj + l31; const float cj = Fc[jcol];
              for (int ts = 0; ts <= tj; ++ts) {
                  f32x16 S;
#pragma unroll
                  for (int i = 0; i < 16; ++i) S[i] = 0.f;
#pragma unroll
                  for (int t = 0; t < 8; ++t) { const bf16x8 A = *(const bf16x8*)(Ks + (32 * ts + l31) * ML_PQ + 16 * t + 8 * hh); const bf16x8 B = *(const bf16x8*)(Qs + jcol * ML_PQ + 16 * t + 8 * hh);
                      S = __builtin_amdgcn_mfma_f32_32x32x16_bf16(A, B, S, 0, 0, 0); }
#pragma unroll
                  for (int i = 0; i < 16; ++i) { const int s = 32 * ts + 8 * (i >> 2) + 4 * hh + (i & 3); if (ts == tj) S[i] = (s <= jcol) ? S[i] : 0.f; den1 += S[i]; }
#pragma unroll
                  for (int t2 = 0; t2 < 2; ++t2) {
                      const u32x4 bw = (u32x4){pk2(S[8 * t2 + 0], S[8 * t2 + 1]), pk2(S[8 * t2 + 2], S[8 * t2 + 3]), pk2(S[8 * t2 + 4], S[8 * t2 + 5]), pk2(S[8 * t2 + 6], S[8 * t2 + 7])};
                      const bf16_t* vp = VT + (32 * tv + l31) * ML_PT + 32 * ts + 16 * t2 + 4 * hh; const u32x2 lo = *(const u32x2*)vp, hi = *(const u32x2*)(vp + 8);
                      const u32x4 aw = (u32x4){lo.x, lo.y, hi.x, hi.y};
                      acc1 = __builtin_amdgcn_mfma_f32_32x32x16_bf16(__builtin_bit_cast(bf16x8, aw), __builtin_bit_cast(bf16x8, bw), acc1, 0, 0, 0); }
              }
              den1 += __shfl_xor(den1, 32);
#pragma unroll
              for (int t = 0; t < 8; ++t) { const bf16x8 A = *(const bf16x8*)(Cb + (32 * tv + l31) * ML_PC + 16 * t + 8 * hh); const bf16x8 B = *(const bf16x8*)(Qs + jcol * ML_PQ + 16 * t + 8 * hh);
                  acc2 = __builtin_amdgcn_mfma_f32_32x32x16_bf16(A, B, acc2, 0, 0, 0); }
              const float ei = Fei[jcol]; const float den = den1 * cj + ei * Fnq[jcol];
              { bf16_t* hp = HT + jcol * ML_PQ + 32 * tv + 4 * hh;
#pragma unroll
                  for (int g4 = 0; g4 < 4; ++g4) { u32x2 o; o.x = pk2(acc1[4 * g4] * cj + ei * acc2[4 * g4], acc1[4 * g4 + 1] * cj + ei * acc2[4 * g4 + 1]);
                      o.y = pk2(acc1[4 * g4 + 2] * cj + ei * acc2[4 * g4 + 2], acc1[4 * g4 + 3] * cj + ei * acc2[4 * g4 + 3]); *(u32x2*)(hp + 8 * g4) = o; }
                  if (tv == 0 && hh == 0) HR[jcol] = (f32x4){Fmt[jcol], FL[jcol], den, 0.f}; }
              const float fs = Fsc[0];
#pragma unroll
              for (int x = 0; x < 2; ++x) { const int tk = 2 * tj + x;
#pragma unroll
                  for (int i = 0; i < 16; ++i) X[x][i] *= fs;
#pragma unroll
                  for (int t = 0; t < 4; ++t) { const bf16x8 A = *(const bf16x8*)(KT + (32 * tk + l31) * ML_PT + 16 * t + 8 * hh); const bf16x8 B = *(const bf16x8*)(VT + (32 * tv + l31) * ML_PT + 16 * t + 8 * hh);
                      X[x] = __builtin_amdgcn_mfma_f32_32x32x16_bf16(A, B, X[x], 0, 0, 0); } }
              { const int k = tid >> 2, part = tid & 3; float kv[8], sm = 0.f;
#pragma unroll
                for (int q2 = 0; q2 < 2; ++q2) { unpack8(*(const u32x4*)(KT + k * ML_PT + 16 * part + 8 * q2), kv);
#pragma unroll
                    for (int e = 0; e < 8; ++e) sm += kv[e]; }
                sm += __shfl_xor(sm, 1); sm += __shfl_xor(sm, 2);
                if (part == 0) Fn[k] = fs * Fn[k] + sm; }
            }
            LDS_BARRIER();
#pragma unroll
            for (int x = 0; x < 2; ++x) { const int tk = 2 * tj + x; bf16_t* cp = Cb + (32 * tv + l31) * ML_PC + 32 * tk + 4 * hh;
#pragma unroll
                for (int g4 = 0; g4 < 4; ++g4) { u32x2 o; o.x = pk2(X[x][4 * g4], X[x][4 * g4 + 1]); o.y = pk2(X[x][4 * g4 + 2], X[x][4 * g4 + 3]); *(u32x2*)(cp + 8 * g4) = o; } }
        }
        __syncthreads();
        ML_FLUSH(n_end - 1);
        { const __amdgpu_buffer_rsrc_t sx_rsrc = __builtin_amdgcn_make_buffer_rsrc(a.ws + WS_SEGX, 0, ML_NSEGU * 16384 * 2, 0x00020000);
          for (int i = tid; i < 2048; i += NTHREADS) { const int v = i >> 4, c8 = i & 15;
              __builtin_amdgcn_raw_buffer_store_b128(*(const u32x4*)(Cb + v * ML_PC + 8 * c8), sx_rsrc, (unsigned)((slot * 16384 + v * 128 + 8 * c8) * 2), 0, 16); }
          float* SN = (float*)(a.ws + WS_SEGN) + (size_t)slot * 132;
          if (tid < 128) __hip_atomic_store(SN + tid, Fn[tid], __ATOMIC_RELAXED, __HIP_MEMORY_SCOPE_AGENT);
          if (w == 7 && lane == 0) { __hip_atomic_store(SN + 128, mstate, __ATOMIC_RELAXED, __HIP_MEMORY_SCOPE_AGENT); __hip_atomic_store(SN + 129, gacc, __ATOMIC_RELAXED, __HIP_MEMORY_SCOPE_AGENT); } }
        asm volatile("s_waitcnt vmcnt(0)" ::: "memory");
        __syncthreads();
#undef ML_LOAD
#undef ML_FLUSH
    }
}
__device__ __forceinline__ void mlstm_chain(const Args& a, int tid, int sid) {
    {
        int b, hd, dir, nseg, slot0; ml_stream_decode(sid, b, hd, dir, nseg, slot0);
        float C[32]; float nn = 0.f, M = 0.f;
#pragma unroll
        for (int i = 0; i < 32; ++i) C[i] = 0.f;
        for (int k = 0; k < nseg; ++k) {
            bf16_t* ST = (bf16_t*)(a.ws + WS_START) + (size_t)(slot0 + k) * 16384; float* STN = (float*)(a.ws + WS_STARTN) + (size_t)(slot0 + k) * 132;
#pragma unroll
            for (int q = 0; q < 4; ++q) *(u32x4*)(ST + tid * 32 + 8 * q) = (u32x4){pk2(C[8 * q], C[8 * q + 1]), pk2(C[8 * q + 2], C[8 * q + 3]), pk2(C[8 * q + 4], C[8 * q + 5]), pk2(C[8 * q + 6], C[8 * q + 7])};
            if (tid < 128) STN[tid] = nn;
            if (tid == 0) STN[128] = M;
            if (k + 1 == nseg) break;
            const bf16_t* SX = (const bf16_t*)(a.ws + WS_SEGX) + (size_t)(slot0 + k) * 16384; const float* SN = (const float*)(a.ws + WS_SEGN) + (size_t)(slot0 + k) * 132;
            const float mend = SN[128], gt = SN[129]; const float M2 = fmaxf(gt + M, mend); const float ca = __expf(gt + M - M2), cb = __expf(mend - M2); M = M2;
#pragma unroll
            for (int q = 0; q < 4; ++q) { float xv[8]; unpack8(*(const u32x4*)(SX + tid * 32 + 8 * q), xv);
#pragma unroll
                for (int e = 0; e < 8; ++e) C[8 * q + e] = ca * C[8 * q + e] + cb * xv[e]; }
            if (tid < 128) nn = ca * nn + cb * SN[tid];
        }
    }
}
__device__ __forceinline__ int ml_slot_of(int row0, int hd, int dir) {
    int b, p0; row_info(row0, b, p0); const int nc = seq_lp(b) >> 6, oc = p0 >> 6; const int n = dir ? nc - 1 - oc : oc; const int k = n < 17 ? 0 : 1 + ((n - 17) >> 4);
    return (b >= NPROMPT ? ((b - 8) * 8 + hd * 2 + dir) * 8 : 128 + (b * 8 + hd * 2 + dir) * 4) + k;
}
constexpr int MF_QCTL = 4 * 128 * 136 * 2 + 64;
constexpr int MF_PITCH = 136;
__device__ __forceinline__ void mlstm_finish(const Args& a, unsigned char* lds, int tid) {
    bf16_t* PROJ = (bf16_t*)(a.ws + WS_PROJ); const float* head_g = a.in[8]; const float* ROWS = (const float*)(a.ws + WS_MLROWS);
    const int lane = tid & 63, w = __builtin_amdgcn_readfirstlane(tid >> 6), jl = lane & 15, g = lane >> 4;
    const int NCH = MROWS / 64;
    volatile int* QC = (volatile int*)(lds + MF_QCTL);
    for (;;) {
        __syncthreads();
        if (tid == 0) QC[0] = (int)atomicAdd((unsigned*)a.ws + 1, 1u);
        __syncthreads();
        const int it = QC[0];
        if (it >= (NCH / 2) * 4) break;
        const int hd = it & 3, ci = (it >> 2) * 2 + (w >> 2);
        int b, p0; row_info(ci * 64, b, p0);
        const int nc = seq_lp(b) >> 6, oc = p0 >> 6;
        int sl[2][2];
#pragma unroll
        for (int st = 0; st < 4; ++st) { const int c2 = st >> 1, sdir = st & 1; sl[c2][sdir] = ml_slot_of(((it >> 2) * 2 + c2) * 64, hd, sdir); }
#pragma unroll
        for (int st = 0; st < 4; ++st) {
            const int c2 = st >> 1, sdir = st & 1;
            if (c2 == 1 && sl[1][sdir] == sl[0][sdir]) continue;
            const bf16_t* src = (const bf16_t*)(a.ws + WS_START) + (size_t)sl[c2][sdir] * 16384; bf16_t* dst = (bf16_t*)lds + st * 128 * MF_PITCH;
#pragma unroll
            for (int q = 0; q < 4; ++q) { const int pc = tid + 512 * q, v = pc >> 4, c8 = pc & 15; *(u32x4*)(dst + v * MF_PITCH + 8 * c8) = *(const u32x4*)(src + v * 128 + 8 * c8); } }
        __syncthreads();
        const int row = ci * 64 + 16 * (w & 3) + jl; const int p = p0 + 16 * (w & 3) + jl;
        const bf16_t* qp = PROJ + (size_t)row * LDP + C_MLQ + hd * 128 + 8 * g;
        bf16x8 qf[4];
#pragma unroll
        for (int t = 0; t < 4; ++t) qf[t] = *(const bf16x8*)(qp + 32 * t);
        float hsum[32];
#pragma unroll
        for (int i = 0; i < 32; ++i) hsum[i] = 0.f;
#pragma unroll
        for (int dir = 0; dir < 2; ++dir) {
            const int n = dir ? nc - 1 - oc : oc; const int kseg = n < 17 ? 0 : 1 + ((n - 17) >> 4);
            const int sid = b >= NPROMPT ? ((b - 8) * 8 + hd * 2 + dir) : (16 + b * 8 + hd * 2 + dir);
            const int slot = (b >= NPROMPT ? sid * 8 : 128 + (sid - 16) * 4) + kseg;
            const bf16_t* ST = (const bf16_t*)lds + (((w >> 2) && sl[1][dir] != sl[0][dir] ? 2 : 0) + dir) * 128 * MF_PITCH; const float* STN = (const float*)(a.ws + WS_STARTN) + (size_t)slot * 132;
            const bf16_t* NUM = (const bf16_t*)((const unsigned char*)a.out + (dir ? DO_HB : DO_HF)) + (size_t)row * 512 + hd * 128 + 8 * g;
            const f32x4 rs = *(const f32x4*)(ROWS + ((size_t)row * 8 + hd * 2 + dir) * 4);
            const float M = STN[128]; const float mf = fmaxf(rs.x, rs.y + M); const float sA = __expf(rs.x - mf), sB = __expf(rs.y + M - mf);
            float nq = 0.f;
#pragma unroll
            for (int t = 0; t < 4; ++t) { float qv[8]; unpack8(__builtin_bit_cast(u32x4, qf[t]), qv); const f32x4 n0 = *(const f32x4*)(STN + 32 * t + 8 * g), n1 = *(const f32x4*)(STN + 32 * t + 8 * g + 4);
                nq += qv[0] * n0.x + qv[1] * n0.y + qv[2] * n0.z + qv[3] * n0.w + qv[4] * n1.x + qv[5] * n1.y + qv[6] * n1.z + qv[7] * n1.w; }
            nq += __shfl_xor(nq, 16); nq += __shfl_xor(nq, 32);
            const float den = rs.z * sA + sB * nq; const float inv = 1.0f / fmaxf(fabsf(den), __expf(-mf));
#pragma unroll
            for (int mp = 0; mp < 4; ++mp) {
                f32x4 acc0 = (f32x4){0.f, 0.f, 0.f, 0.f}, acc1 = (f32x4){0.f, 0.f, 0.f, 0.f};
                const bf16_t* sr = ST + (32 * mp + 8 * (jl >> 2) + (jl & 3)) * MF_PITCH + 8 * g;
#pragma unroll
                for (int t = 0; t < 4; ++t) { acc0 = __builtin_amdgcn_mfma_f32_16x16x32_bf16(*(const bf16x8*)(sr + 32 * t), qf[t], acc0, 0, 0, 0);
                    acc1 = __builtin_amdgcn_mfma_f32_16x16x32_bf16(*(const bf16x8*)(sr + 4 * MF_PITCH + 32 * t), qf[t], acc1, 0, 0, 0); }
                float nv[8]; unpack8(*(const u32x4*)(NUM + 32 * mp), nv);
#pragma unroll
                for (int i = 0; i < 4; ++i) { hsum[8 * mp + i] += (nv[i] * sA + sB * acc0[i]) * inv; hsum[8 * mp + 4 + i] += (nv[4 + i] * sA + sB * acc1[i]) * inv; } }
        }
        bf16_t* prow = PROJ + (size_t)row * LDP; float s1 = 0.f;
#pragma unroll
        for (int mp = 0; mp < 4; ++mp) { float ov[8]; unpack8(*(const u32x4*)(prow + C_MLO + hd * 128 + 32 * mp + 8 * g), ov);
#pragma unroll
            for (int e = 0; e < 8; ++e) { hsum[8 * mp + e] *= sigmoidf_(ov[e]); s1 += hsum[8 * mp + e]; } }
        s1 += __shfl_xor(s1, 16); s1 += __shfl_xor(s1, 32); const float mu = s1 * (1.f / 128.f); float s2 = 0.f;
#pragma unroll
        for (int i = 0; i < 32; ++i) { hsum[i] -= mu; s2 += hsum[i] * hsum[i]; }
        s2 += __shfl_xor(s2, 16); s2 += __shfl_xor(s2, 32); const float rstd = rsqrtf(s2 * (1.f / 128.f) + EPS);
        if (p >= 48) {
#pragma unroll
            for (int mp = 0; mp < 4; ++mp) { const int cc = hd * 128 + 32 * mp + 8 * g; float zv[8]; unpack8(*(const u32x4*)(prow + C_MLZ + cc), zv); const f32x4 h0 = *(const f32x4*)(head_g + cc), h1 = *(const f32x4*)(head_g + cc + 4);
                const float* hs = hsum + 8 * mp;
                *(u32x4*)(prow + C_YB + cc) = (u32x4){pk2(hs[0] * rstd * h0.x * siluf_(zv[0]), hs[1] * rstd * h0.y * siluf_(zv[1])), pk2(hs[2] * rstd * h0.z * siluf_(zv[2]), hs[3] * rstd * h0.w * siluf_(zv[3])),
                                                      pk2(hs[4] * rstd * h1.x * siluf_(zv[4]), hs[5] * rstd * h1.y * siluf_(zv[5])), pk2(hs[6] * rstd * h1.z * siluf_(zv[6]), hs[7] * rstd * h1.w * siluf_(zv[7]))}; } }
    }
}
constexpr int NA3_K = 0, NA3_KM = 73728, NA3_VT = 75776, NA3_PITCH = 600, NA3_RPB = NA3_VT + 64 * NA3_PITCH * 2, NA_CTL = NA3_RPB + 15 * 64 * 4, NA_END = NA_CTL + 16;
static_assert(NA_END <= LDS_BARST, "NA LDS map");
constexpr int NA_UNITS = 2 * 8 * 16 + 8 * 8 * 8;
__device__ __forceinline__ void na_vt_store(bf16_t* vt, const u32x4 vv) {
    vt[0 * NA3_PITCH] = (bf16_t)(vv.x & 0xffffu); vt[1 * NA3_PITCH] = (bf16_t)(vv.x >> 16); vt[2 * NA3_PITCH] = (bf16_t)(vv.y & 0xffffu); vt[3 * NA3_PITCH] = (bf16_t)(vv.y >> 16);
    vt[4 * NA3_PITCH] = (bf16_t)(vv.z & 0xffffu); vt[5 * NA3_PITCH] = (bf16_t)(vv.z >> 16); vt[6 * NA3_PITCH] = (bf16_t)(vv.w & 0xffffu); vt[7 * NA3_PITCH] = (bf16_t)(vv.w >> 16);
}
__device__ __forceinline__ void na_unit(const Args& a, unsigned char* lds, int tid, int u) {
    bf16_t* PROJ = (bf16_t*)(a.ws + WS_PROJ); const float* rpb = a.in[6];
    const int lane = tid & 63, w = __builtin_amdgcn_readfirstlane(tid >> 6), ql = lane & 15, g = lane >> 4;
    unsigned char* KR = lds + NA3_K; unsigned char* KM = lds + NA3_KM; bf16_t* VT = (bf16_t*)(lds + NA3_VT); float* RPB = (float*)(lds + NA3_RPB);
    const int cb = w & 3, rr = w >> 2;
    const int kc0 = min(max(16 * cb - 8, 0), 32);
    const int cq = 16 * cb + ql, c0q = min(max(cq - 8, 0), 48);
    float mneg[2][4];
#pragma unroll
    for (int hf = 0; hf < 2; ++hf)
#pragma unroll
        for (int i = 0; i < 4; ++i) { const int kc = kc0 + 16 * hf + 4 * g + i; mneg[hf][i] = ((kc >= c0q) && (kc < c0q + 16)) ? 0.f : -INFINITY; }
    const int dcb = kc0 + 4 * g - cq + 15 + 16;
    const int ksw0 = ((0 + g) ^ (ql & 7)) << 4, ksw1 = ((4 + g) ^ (ql & 7)) << 4;
    int b, h, seg;
    if (u < 256) { b = 8 + (u >> 7); h = (u >> 4) & 7; seg = u & 15; } else { u -= 256; b = u >> 6; h = (u >> 3) & 7; seg = u & 7; }
    const int rows = b < NPROMPT ? 64 : 128, base = seq_base(b);
    const int r_begin = seg * 8, r_end = r_begin + 8;
    const bf16_t* kvbase = PROJ + (size_t)(base + 64) * LDP + h * 64;
    for (int i = tid; i < 960; i += NTHREADS) { const int rrow = i >> 6, cc = (i & 63) - 16; RPB[i] = (cc >= 0 && cc < 31) ? rpb[(h * 15 + rrow) * 31 + cc] * 1.4426950408889634f : 0.f; }
    if (tid < 128) { const int t = tid >> 3, c = tid & 7; *(u32x4*)(KM + t * 128 + ((c ^ (t & 7)) << 4)) = *(const u32x4*)(PROJ + (size_t)(base + 48 + t) * LDP + C_NAK + h * 64 + 8 * c); }
    else if (tid < 256) { const int t = tid & 15, c = (tid >> 4) & 7; na_vt_store(VT + (8 * c) * NA3_PITCH + t, *(const u32x4*)(PROJ + (size_t)(base + 48 + t) * LDP + C_NAV + h * 64 + 8 * c)); }
    int loaded = min(max(r_begin - 4, 0), rows - 8);
    { const int need = min(max(r_begin + 1 - 4, 0), rows - 8) + 8;
      for (int kr = loaded; kr < need; kr += 3) {
          u32x4 tk[3], tv[3];
#pragma unroll
          for (int q = 0; q < 3; ++q) if (kr + q < need) { tk[q] = *(const u32x4*)(kvbase + (size_t)((kr + q) * 64 + (tid >> 3)) * LDP + C_NAK + 8 * (tid & 7)); tv[q] = *(const u32x4*)(kvbase + (size_t)((kr + q) * 64 + lane) * LDP + C_NAV + 8 * w); }
#pragma unroll
          for (int q = 0; q < 3; ++q) if (kr + q < need) { const int slot = (kr + q) % 9; *(u32x4*)(KR + slot * 8192 + (tid >> 3) * 128 + (((tid & 7) ^ ((tid >> 3) & 7)) << 4)) = tk[q]; na_vt_store(VT + (8 * w) * NA3_PITCH + 16 + slot * 64 + lane, tv[q]); } }
      loaded = need; }
    if (seg == 0) {
        __syncthreads();
        if (w == 0) {
            bf16_t* qp = PROJ + (size_t)(base + 48 + ql) * LDP; bf16x8 qf[2];
#pragma unroll
            for (int s = 0; s < 2; ++s) qf[s] = *(const bf16x8*)(qp + C_NAQ + h * 64 + 32 * s + 8 * g);
            f32x4 acc = (f32x4){0.f, 0.f, 0.f, 0.f};
            acc = __builtin_amdgcn_mfma_f32_16x16x32_bf16(*(const bf16x8*)(KM + ql * 128 + ksw0), qf[0], acc, 0, 0, 0);
            acc = __builtin_amdgcn_mfma_f32_16x16x32_bf16(*(const bf16x8*)(KM + ql * 128 + ksw1), qf[1], acc, 0, 0, 0);
            acc = acc * (0.125f * 1.4426950408889634f);
            float mx = fmaxf(fmaxf(acc[0], acc[1]), fmaxf(acc[2], acc[3])); mx = fmaxf(mx, __shfl_xor(mx, 16)); mx = fmaxf(mx, __shfl_xor(mx, 32));
            float sum = 0.f;
#pragma unroll
            for (int i = 0; i < 4; ++i) { acc[i] = __builtin_amdgcn_exp2f(acc[i] - mx); sum += acc[i]; }
            sum += __shfl_xor(sum, 16); sum += __shfl_xor(sum, 32);
            const u32x4 bw = (u32x4){pk2(acc[0], acc[1]), pk2(acc[2], acc[3]), 0u, 0u}; const float inv = 1.0f / sum;
#pragma unroll
            for (int dt = 0; dt < 4; ++dt) { const u32x2 lo = *(const u32x2*)(VT + (size_t)(16 * dt + ql) * NA3_PITCH + 4 * g); const u32x4 aw = (u32x4){lo.x, lo.y, 0u, 0u};
                const f32x4 O = __builtin_amdgcn_mfma_f32_16x16x32_bf16(__builtin_bit_cast(bf16x8, aw), __builtin_bit_cast(bf16x8, bw), (f32x4){0.f, 0.f, 0.f, 0.f}, 0, 0, 0);
                const u32x2 zv = *(const u32x2*)(qp + C_NAZ + h * 64 + 16 * dt + 4 * g);
                u32x2 o; o.x = pk2(O[0] * inv * siluf_(bf2f(zv.x & 0xffffu)), O[1] * inv * siluf_(bf2f(zv.x >> 16))); o.y = pk2(O[2] * inv * siluf_(bf2f(zv.y & 0xffffu)), O[3] * inv * siluf_(bf2f(zv.y >> 16)));
                *(u32x2*)(qp + C_YA + h * 64 + 16 * dt + 4 * g) = o; }
        }
    }
    bf16x8 qn[2]; u32x2 zn[4];
    { const bf16_t* qp = PROJ + (size_t)(base + 64 + (r_begin + rr) * 64 + 16 * cb + ql) * LDP + h * 64;
#pragma unroll
      for (int s = 0; s < 2; ++s) qn[s] = *(const bf16x8*)(qp + C_NAQ + 32 * s + 8 * g);
#pragma unroll
      for (int dt = 0; dt < 4; ++dt) zn[dt] = *(const u32x2*)(qp + C_NAZ + 16 * dt + 4 * g); }
    int npre = 0; u32x4 prk[2], prv[2];
    for (int r = r_begin; r < r_end; r += 2) {
#pragma unroll
        for (int q = 0; q < 2; ++q) if (q < npre) { const int slot = (loaded + q) % 9; *(u32x4*)(KR + slot * 8192 + (tid >> 3) * 128 + (((tid & 7) ^ ((tid >> 3) & 7)) << 4)) = prk[q]; na_vt_store(VT + (8 * w) * NA3_PITCH + 16 + slot * 64 + lane, prv[q]); }
        loaded += npre;
        LDS_BARRIER();
        npre = 0;
        if (r + 2 < r_end) { npre = min(max(r + 3 - 4, 0), rows - 8) + 8 - loaded;
#pragma unroll
            for (int q = 0; q < 2; ++q) if (q < npre) { prk[q] = *(const u32x4*)(kvbase + (size_t)((loaded + q) * 64 + (tid >> 3)) * LDP + C_NAK + 8 * (tid & 7)); prv[q] = *(const u32x4*)(kvbase + (size_t)((loaded + q) * 64 + lane) * LDP + C_NAV + 8 * w); } }
        const int rw = r + rr, r0 = min(max(rw - 4, 0), rows - 8);
        bf16_t* qp = PROJ + (size_t)(base + 64 + rw * 64 + 16 * cb + ql) * LDP + h * 64;
        bf16x8 qf[2] = {qn[0], qn[1]}; u32x2 zf[4] = {zn[0], zn[1], zn[2], zn[3]};
        if (r + 2 < r_end) { const bf16_t* qp2 = qp + (size_t)128 * LDP;
#pragma unroll
            for (int s = 0; s < 2; ++s) qn[s] = *(const bf16x8*)(qp2 + C_NAQ + 32 * s + 8 * g);
#pragma unroll
            for (int dt = 0; dt < 4; ++dt) zn[dt] = *(const u32x2*)(qp2 + C_NAZ + 16 * dt + 4 * g); }
        f32x4 S[17];
        { f32x4 acc = (f32x4){0.f, 0.f, 0.f, 0.f};
          acc = __builtin_amdgcn_mfma_f32_16x16x32_bf16(*(const bf16x8*)(KM + ql * 128 + ksw0), qf[0], acc, 0, 0, 0);
          acc = __builtin_amdgcn_mfma_f32_16x16x32_bf16(*(const bf16x8*)(KM + ql * 128 + ksw1), qf[1], acc, 0, 0, 0);
          S[0] = acc * (0.125f * 1.4426950408889634f); }
#pragma unroll
        for (int t = 1; t < 17; ++t) { const int w8 = (t - 1) >> 1, hf = (t - 1) & 1;
            const unsigned char* kp = KR + ((r0 + w8) % 9) * 8192 + (kc0 + 16 * hf + ql) * 128;
            f32x4 acc = (f32x4){0.f, 0.f, 0.f, 0.f};
            acc = __builtin_amdgcn_mfma_f32_16x16x32_bf16(*(const bf16x8*)(kp + ksw0), qf[0], acc, 0, 0, 0);
            acc = __builtin_amdgcn_mfma_f32_16x16x32_bf16(*(const bf16x8*)(kp + ksw1), qf[1], acc, 0, 0, 0);
            const float* rp = RPB + (r0 + w8 - rw + 7) * 64 + dcb + 16 * hf;
#pragma unroll
            for (int i = 0; i < 4; ++i) acc[i] = acc[i] * (0.125f * 1.4426950408889634f) + rp[i] + mneg[hf][i];
            S[t] = acc;
            if ((t & 3) == 0) asm volatile("" ::: "memory"); }
        float mx = -INFINITY;
#pragma unroll
        for (int t = 0; t < 17; ++t) mx = fmaxf(mx, fmaxf(fmaxf(S[t][0], S[t][1]), fmaxf(S[t][2], S[t][3])));
        mx = fmaxf(mx, __shfl_xor(mx, 16)); mx = fmaxf(mx, __shfl_xor(mx, 32));
        float sum = 0.f;
#pragma unroll
        for (int t = 0; t < 17; ++t)
#pragma unroll
            for (int i = 0; i < 4; ++i) { const float p = __builtin_amdgcn_exp2f(S[t][i] - mx); S[t][i] = p; sum += p; }
        sum += __shfl_xor(sum, 16); sum += __shfl_xor(sum, 32);
        f32x4 O[4];
#pragma unroll
        for (int dt = 0; dt < 4; ++dt) O[dt] = (f32x4){0.f, 0.f, 0.f, 0.f};
        const bf16_t* vtx = VT + (size_t)ql * NA3_PITCH + 4 * g;
#pragma unroll
        for (int ks = 0; ks < 9; ++ks) {
            const int ta = 2 * ks, tb = 2 * ks + 1;
            const u32x4 bw = (u32x4){pk2(S[ta][0], S[ta][1]), pk2(S[ta][2], S[ta][3]), tb < 17 ? pk2(S[tb < 17 ? tb : 16][0], S[tb < 17 ? tb : 16][1]) : 0u, tb < 17 ? pk2(S[tb < 17 ? tb : 16][2], S[tb < 17 ? tb : 16][3]) : 0u};
            const int offa = ta == 0 ? 0 : 16 + ((r0 + ((ta - 1) >> 1)) % 9) * 64 + kc0 + 16 * ((ta - 1) & 1);
            const int offb = tb < 17 ? 16 + ((r0 + ((tb - 1) >> 1)) % 9) * 64 + kc0 + 16 * ((tb - 1) & 1) : 0;
#pragma unroll
            for (int dt = 0; dt < 4; ++dt) { const u32x2 lo = *(const u32x2*)(vtx + 16 * dt * NA3_PITCH + offa); u32x2 hi = (u32x2){0u, 0u};
                if (tb < 17) hi = *(const u32x2*)(vtx + 16 * dt * NA3_PITCH + offb);
                const u32x4 aw = (u32x4){lo.x, lo.y, hi.x, hi.y};
                O[dt] = __builtin_amdgcn_mfma_f32_16x16x32_bf16(__builtin_bit_cast(bf16x8, aw), __builtin_bit_cast(bf16x8, bw), O[dt], 0, 0, 0); }
        }
        const float inv = 1.0f / sum;
#pragma unroll
        for (int dt = 0; dt < 4; ++dt) { const u32x2 zv = zf[dt];
            u32x2 o; o.x = pk2(O[dt][0] * inv * siluf_(bf2f(zv.x & 0xffffu)), O[dt][1] * inv * siluf_(bf2f(zv.x >> 16)));
            o.y = pk2(O[dt][2] * inv * siluf_(bf2f(zv.y & 0xffffu)), O[dt][3] * inv * siluf_(bf2f(zv.y >> 16)));
            *(u32x2*)(qp + C_YA + 16 * dt + 4 * g) = o; }
        LDS_BARRIER();
    }
}
__global__ void __launch_bounds__(NTHREADS, 2) hybrid_fwd(Args args) {
    extern __shared__ __attribute__((aligned(16))) unsigned char lds[];
    const int tid = threadIdx.x, lane = tid & 63, wave = __builtin_amdgcn_readfirstlane(tid >> 6);
    const int G = gridDim.x, gw = blockIdx.x * NWAVES + wave, NGW = G * NWAVES;
    unsigned char* ws = args.ws;
    bf16_t* PROJ = (bf16_t*)(ws + WS_PROJ);
    unsigned char* mgq_lo = (unsigned char*)args.out + DO_MGQ_LO; unsigned char* mgq_hi = ws + WS_MGQ_HI;
    volatile LAS unsigned* barst = (volatile LAS unsigned*)((LAS unsigned char*)lds + LDS_BARST);
    if (tid < 2) barst[tid] = 0u;
    __syncthreads();
    XcdBarrier bar = xcd_barrier_post((unsigned*)(ws + WS_BAR), barst);
    const int lo = args.ph_lo, hi = args.ph_hi;
#define IN(k) (lo <= (k) && (k) < hi)
#define SEAM(k) do { if (IN(k) && IN((k) + 1)) xcd_barrier(bar); } while (0)
    if (args.coop == 2) cg::this_grid().sync();
    if (IN(0)) phase0(args, lds, gw, NGW, wave, lane);
    SEAM(0);
    if (IN(1)) {   pg8::Gemm g{(const bf16_t*)((unsigned char*)args.out + DO_XN), (const bf16_t*)(ws + WS_W1T), MPAD, N1, 1024, 1024, 1024, 0}; pg8::StaticOrder S; S.init(MPAD, N1, G, (int)blockIdx.x);
        pg8::EpiProj E{PROJ, mgq_lo, mgq_hi, (float*)(ws + WS_GATES), (const float*)(ws + WS_BIAS1), (bf16_t*)(ws + WS_HALO)};
        pg8::gemm_phase<pg8::EpiProj, pg8::StaticOrder, true, true>((PG8_LAS unsigned char*)lds, g, S, E); }
    SEAM(1);
    if (IN(2)) { conv_phase(args, gw, NGW, lane); xcd_barrier(bar); }
    if (IN(2)) {   volatile int* QCTL = (volatile int*)(lds + LDS_BARST - 32);
#define Q_NEXT(u_) do { __syncthreads(); if (tid == 0) QCTL[0] = (int)atomicAdd((unsigned*)ws, 1u); __syncthreads(); u_ = QCTL[0]; } while (0)
        int u; Q_NEXT(u);
        while (u < ML_NSEGU) { mlstm_segment(args, lds, tid, u);
            const int sid = u < 128 ? (u >> 3) : 16 + ((u - 128) >> 2); const unsigned nseg = u < 128 ? 8u : 4u;
            if (tid == 0) QCTL[1] = (__hip_atomic_fetch_add((unsigned*)(ws + WS_SEGCNT) + sid, 1u, __ATOMIC_RELAXED, __HIP_MEMORY_SCOPE_AGENT) == nseg - 1u) ? 1 : 0;
            __syncthreads();
            if (QCTL[1]) { __builtin_amdgcn_fence(__ATOMIC_ACQUIRE, "agent"); asm volatile("s_waitcnt vmcnt(0)" ::: "memory"); mlstm_chain(args, tid, sid); }
            Q_NEXT(u); }
        while (u < ML_NSEGU + NA_UNITS) { na_unit(args, lds, tid, u - ML_NSEGU); Q_NEXT(u); }
#undef Q_NEXT
    }
    SEAM(2);
    if (IN(3)) mlstm_finish(args, lds, tid);
    SEAM(3);
    if (IN(4)) {   pg8::StaticOrder S; S.init(NTOK, 1024, G, (int)blockIdx.x);
        { pg8::Gemm g{PROJ + C_YA, (const bf16_t*)(ws + WS_WAT), NTOK, 1024, 512, LDP, 512, 1}; pg8::EpiMix<false> E{PROJ + C_MIX, mgq_lo, mgq_hi};
          pg8::gemm_phase<pg8::EpiMix<false>, pg8::StaticOrder, true, true>((PG8_LAS unsigned char*)lds, g, S, E); }
        __syncthreads();
        { pg8::Gemm g{PROJ + C_YB, (const bf16_t*)(ws + WS_WBT), NTOK, 1024, 512, LDP, 512, 1}; pg8::EpiMix<true> E{PROJ + C_MIX, mgq_lo, mgq_hi};
          pg8::gemm_phase<pg8::EpiMix<true>, pg8::StaticOrder, true, true>((PG8_LAS unsigned char*)lds, g, S, E); } }
    SEAM(4);
    if (IN(5)) {   pg8::Gemm g{PROJ + C_MIX, (const bf16_t*)(ws + WS_WOT), NTOK, 1024, 1024, LDP, 1024, 0}; pg8::StaticOrder S; S.init(NTOK, 1024, G, (int)blockIdx.x);
        pg8::EpiY E{PROJ + C_Y, (float*)(ws + WS_SS)};
        pg8::gemm_phase<pg8::EpiY, pg8::StaticOrder, true, true>((PG8_LAS unsigned char*)lds, g, S, E); }
    SEAM(5);
    if (IN(6)) phase_out(args, gw, NGW, lane);
#undef IN
#undef SEAM
}

extern "C" void kernel_launch(void* const* d_in, const int*  , int n_in, void* d_out, int out_size, void* d_ws, size_t ws_size, hipStream_t stream) {
    static int grid = 0;
    if (grid == 0) {
        if (n_in != 13 || out_size != NTOK * DM || ws_size < WS_END) { fprintf(stderr, "kernel_launch: unexpected shapes (n_in %d, out %d, ws %zu, need %zu)\n", n_in, out_size, ws_size, (size_t)WS_END); grid = -1; return; }
        int dev = 0, cus = 0, per_cu = 0;
        if (hipGetDevice(&dev) != hipSuccess || hipDeviceGetAttribute(&cus, hipDeviceAttributeMultiprocessorCount, dev) != hipSuccess) { fprintf(stderr, "kernel_launch: device query failed\n"); grid = -1; return; }
        if (hipFuncSetAttribute((const void*)hybrid_fwd, hipFuncAttributeMaxDynamicSharedMemorySize, LDS_BYTES) != hipSuccess) { fprintf(stderr, "kernel_launch: hipFuncSetAttribute failed\n"); grid = -1; return; }
        if (hipOccupancyMaxActiveBlocksPerMultiprocessor(&per_cu, (const void*)hybrid_fwd, NTHREADS, LDS_BYTES) != hipSuccess || per_cu < 1) { fprintf(stderr, "kernel_launch: occupancy query says %d\n", per_cu); per_cu = 1; }
        (void)hipGetLastError();
        grid = cus;
    }
    if (grid < 0) return;
    if (hipMemsetAsync(d_ws, 0, WS_CTL_ZERO, stream) != hipSuccess) { fprintf(stderr, "kernel_launch: hipMemsetAsync failed\n"); return; }
    Args a{};
    for (int i = 0; i < 13; ++i) a.in[i] = (const float*)d_in[i];
    a.out = (float*)d_out; a.ws = (unsigned char*)d_ws; a.ph_lo = 0; a.ph_hi = 7; a.coop = 1;
    void* kargs[] = {&a};
    const hipError_t e = hipLaunchCooperativeKernel((const void*)hybrid_fwd, dim3(grid), dim3(NTHREADS), kargs, LDS_BYTES, stream);
    if (e != hipSuccess) fprintf(stderr, "cooperative launch failed: %s (grid %d)\n", hipGetErrorString(e), grid);
}
```
